# Optimizing an MI355X kernel written in HIP

```python
import math
import jax, jax.numpy as jnp
from jax import lax
import numpy as np


D_MODEL = 1024
BATCH = 4
SEQ = 4096
DEPTH = 1
DEC_BATCH = 128
DEC_SEQ = 1
PAST_LEN = 8192
PAGE_SIZE = 128

HEAD_DIM = 64
MIX_WIDTH = D_MODEL
N_HEADS_A = MIX_WIDTH // 2 // HEAD_DIM
N_HEADS_B = MIX_WIDTH // 2 // HEAD_DIM
N_KV_B = N_HEADS_B // 4
GQA_GROUP = N_HEADS_B // N_KV_B
A_PATTERNS = ((128, 1), (512, 4), (2048, 16))
A_WINDOW_MAX = 2048
B_WINDOW = 128
BLK = 128
D_FF = 2816
NUM_BUCKETS = 32
MAX_DISTANCE = 2048
N_HEADS_TOTAL = N_HEADS_A + N_HEADS_B
ALPHA = (2 * DEPTH) ** 0.25
BETA = (8 * DEPTH) ** -0.25
LN_EPS = 1e-5
NEG = -1e30
SCALE = HEAD_DIM ** -0.5
PROJ_COLS = 3 * N_HEADS_A * HEAD_DIM + N_HEADS_B * HEAD_DIM + 2 * N_KV_B * HEAD_DIM

kernel_name = "hymba_dilated_swa_sink_macaron_deepnorm_step"


def t5_bucket(n):
    max_exact = NUM_BUCKETS // 2
    nf = jnp.maximum(n, 1).astype(jnp.float32)
    large = max_exact + (jnp.log(nf / max_exact) / math.log(MAX_DISTANCE / max_exact)
                         * (NUM_BUCKETS - max_exact)).astype(jnp.int32)
    return jnp.where(n < max_exact, n, jnp.minimum(large, NUM_BUCKETS - 1))


def layer_norm(x, g, b):
    xf = x.astype(jnp.float32)
    mu = jnp.mean(xf, -1, keepdims=True)
    var = jnp.mean(jnp.square(xf - mu), -1, keepdims=True)
    return ((xf - mu) * lax.rsqrt(var + LN_EPS) * g + b).astype(x.dtype)


def swiglu(h, wg, wu, wd):
    return (jax.nn.silu(h @ wg) * (h @ wu)) @ wd


def softmax_parts(s, sink):
    m = jnp.max(s, -1, keepdims=True)
    if sink is not None:
        m = jnp.maximum(m, sink)
    p = jnp.exp(s - m)
    den = jnp.sum(p, -1, keepdims=True)
    if sink is not None:
        den = den + jnp.exp(sink - m)
    return p, den, m


def banded_attn(q, k, v, bias_heads, step, win_units, sink):
    N, L, Hk, G, hd = q.shape
    nb = L // BLK
    qb = q.reshape(N, nb, BLK, Hk, G, hd)
    kb = k.reshape(N, nb, BLK, Hk, hd)
    vb = v.reshape(N, nb, BLK, Hk, hd)
    pad = ((0, 0), (1, 0), (0, 0), (0, 0), (0, 0))
    kk = jnp.concatenate([jnp.pad(kb, pad)[:, :-1], kb], axis=2)
    vv = jnp.concatenate([jnp.pad(vb, pad)[:, :-1], vb], axis=2)
    dist = jnp.arange(BLK)[:, None] + BLK - jnp.arange(2 * BLK)[None, :]
    valid = (dist >= 0) & (dist <= win_units)
    bias = bias_heads[t5_bucket(jnp.maximum(dist, 0) * step)].astype(jnp.float32)
    bias = jnp.where(valid[..., None], bias, NEG)
    bias = bias.transpose(2, 0, 1).reshape(Hk, G, BLK, 2 * BLK)
    first = (jnp.arange(nb)[:, None] == 0) & (jnp.arange(2 * BLK)[None, :] < BLK)
    s = jnp.einsum('nbqhgd,nbkhd->nbhgqk', qb, kk).astype(jnp.float32) * SCALE + bias
    s = jnp.where(first[None, :, None, None, None, :], NEG, s)
    sink_b = None if sink is None else sink.astype(jnp.float32).reshape(1, 1, Hk, G, 1, 1)
    p, den, m = softmax_parts(s, sink_b)
    o = jnp.einsum('nbhgqk,nbkhd->nbqhgd', p, vv.astype(jnp.float32))
    o = o / den[..., 0].transpose(0, 1, 4, 2, 3)[..., None]
    lse = (m + jnp.log(den))[..., 0].transpose(0, 1, 4, 2, 3)
    return o.reshape(N, L, Hk, G, hd), lse.reshape(N, L, Hk, G)


def gathered_attn(q, kfull, vfull, base, bias_heads, step, win_units, sink):
    N, T, Hk, G, hd = q.shape
    i = jnp.arange(win_units + 1)
    idx = base + jnp.arange(T)[:, None] - step * i[None, :]
    valid = idx >= 0
    idxc = jnp.maximum(idx, 0)
    kg = kfull[:, idxc]
    vg = vfull[:, idxc]
    bias = bias_heads[t5_bucket(i * step)].astype(jnp.float32).T.reshape(Hk, G, win_units + 1)
    s = jnp.einsum('nthgd,ntkhd->nthgk', q, kg).astype(jnp.float32) * SCALE + bias
    s = jnp.where(valid[None, :, None, None, :], s, NEG)
    sink_b = None if sink is None else sink.astype(jnp.float32).reshape(1, 1, Hk, G, 1)
    p, den, m = softmax_parts(s, sink_b)
    o = jnp.einsum('nthgk,ntkhd->nthgd', p, vg.astype(jnp.float32)) / den
    return o, (m + jnp.log(den))[..., 0]


def split_proj(h, w_in):
    na = N_HEADS_A * HEAD_DIM
    nq = N_HEADS_B * HEAD_DIM
    nkv = N_KV_B * HEAD_DIM
    pre = h.shape[:-1]
    proj = h @ w_in
    qa, ka, va, qb, kb, vb = jnp.split(proj, [na, 2 * na, 3 * na, 3 * na + nq, 3 * na + nq + nkv], axis=-1)
    return (qa.reshape(*pre, N_HEADS_A, HEAD_DIM), ka.reshape(*pre, N_HEADS_A, HEAD_DIM),
            va.reshape(*pre, N_HEADS_A, HEAD_DIM), qb.reshape(*pre, N_KV_B, GQA_GROUP, HEAD_DIM),
            kb.reshape(*pre, N_KV_B, HEAD_DIM), vb.reshape(*pre, N_KV_B, HEAD_DIM))


def merge_branches(outs, lses):
    w = jax.nn.softmax(jnp.stack(lses), axis=0)
    return jnp.einsum('rbsh,rbshd->bshd', w, jnp.stack(outs))


def mixer_prompt(h, w_in, w_out, sinks, rel_bias):
    Bn, S, _ = h.shape
    qa, ka, va, qb, kb, vb = split_proj(h, w_in)
    outs, lses = [], []
    for window, dil in A_PATTERNS:
        L = S // dil
        Lp = -(-L // BLK) * BLK

        def to_res(t):
            t = t.reshape(Bn, L, dil, N_HEADS_A, HEAD_DIM).transpose(0, 2, 1, 3, 4)
            t = t.reshape(Bn * dil, L, N_HEADS_A, HEAD_DIM)
            return jnp.pad(t, ((0, 0), (0, Lp - L), (0, 0), (0, 0)))

        o, lse = banded_attn(to_res(qa)[:, :, :, None, :], to_res(ka), to_res(va),
                             rel_bias[:, :N_HEADS_A], dil, window // dil, None)
        o = o[:, :L, :, 0].reshape(Bn, dil, L, N_HEADS_A, HEAD_DIM).transpose(0, 2, 1, 3, 4)
        lse = lse[:, :L, :, 0].reshape(Bn, dil, L, N_HEADS_A).transpose(0, 2, 1, 3)
        outs.append(o.reshape(Bn, S, N_HEADS_A, HEAD_DIM))
        lses.append(lse.reshape(Bn, S, N_HEADS_A))
    oa = merge_branches(outs, lses)
    ob, _ = banded_attn(qb, kb, vb, rel_bias[:, N_HEADS_A:], 1, B_WINDOW, sinks)
    mixed = jnp.concatenate([oa.reshape(Bn, S, -1), ob.reshape(Bn, S, -1)], -1).astype(h.dtype)
    ra = min(A_WINDOW_MAX, S)
    rb = min(B_WINDOW, S)
    return mixed @ w_out, ka[:, S - ra:], va[:, S - ra:], kb[:, S - rb:], vb[:, S - rb:]


def mixer_sample(h, ca_k, ca_v, cb_k, cb_v, w_in, w_out, sinks, rel_bias):
    Bn, T, _ = h.shape
    qa, ka, va, qb, kb, vb = split_proj(h, w_in)
    kfa = jnp.concatenate([ca_k, ka.astype(ca_k.dtype)], 1)
    vfa = jnp.concatenate([ca_v, va.astype(ca_v.dtype)], 1)
    outs, lses = [], []
    for window, dil in A_PATTERNS:
        o, lse = gathered_attn(qa[:, :, :, None, :], kfa, vfa, ca_k.shape[1],
                               rel_bias[:, :N_HEADS_A], dil, window // dil, None)
        outs.append(o[:, :, :, 0])
        lses.append(lse[:, :, :, 0])
    oa = merge_branches(outs, lses)
    kfb = jnp.concatenate([cb_k, kb.astype(cb_k.dtype)], 1)
    vfb = jnp.concatenate([cb_v, vb.astype(cb_v.dtype)], 1)
    ob, _ = gathered_attn(qb, kfb, vfb, cb_k.shape[1], rel_bias[:, N_HEADS_A:], 1, B_WINDOW, sinks)
    mixed = jnp.concatenate([oa.reshape(Bn, T, -1), ob.reshape(Bn, T, -1)], -1).astype(h.dtype)
    return mixed @ w_out, ka, va, kb, vb


def trunk(x, c, mixer, w_ada, b_ada, ffn1_wg, ffn1_wu, ffn1_wd, ffn2_wg, ffn2_wu, ffn2_wd, ln_g, ln_b):
    ak, av, bk, bv = [], [], [], []
    for l in range(DEPTH):
        mod = (jax.nn.silu(c) @ w_ada[l] + b_ada[l]).reshape(c.shape[0], 9, 1, D_MODEL)
        h = x * (1 + mod[:, 1]) + mod[:, 0]
        x = layer_norm(ALPHA * x + 0.5 * mod[:, 2] * swiglu(h, ffn1_wg[l], ffn1_wu[l], ffn1_wd[l]),
                       ln_g[l, 0], ln_b[l, 0])
        h = x * (1 + mod[:, 4]) + mod[:, 3]
        out, k_a, v_a, k_b, v_b = mixer(l, h)
        x = layer_norm(ALPHA * x + mod[:, 5] * out, ln_g[l, 1], ln_b[l, 1])
        h = x * (1 + mod[:, 7]) + mod[:, 6]
        x = layer_norm(ALPHA * x + 0.5 * mod[:, 8] * swiglu(h, ffn2_wg[l], ffn2_wu[l], ffn2_wd[l]),
                       ln_g[l, 2], ln_b[l, 2])
        ak.append(k_a); av.append(v_a); bk.append(k_b); bv.append(v_b)
    return x, jnp.stack(ak), jnp.stack(av), jnp.stack(bk), jnp.stack(bv)


def setup_inputs(seed: int = 0) -> dict:
    key = jax.random.key(seed)
    ks = jax.random.split(key, 24)

    def nrm(k, shape, s):
        return jax.random.normal(k, shape, jnp.float32) * s

    a_rows = min(A_WINDOW_MAX, PAST_LEN)
    b_rows = min(B_WINDOW, PAST_LEN)
    na = N_HEADS_A * HEAD_DIM
    nq = N_HEADS_B * HEAD_DIM
    nkv = N_KV_B * HEAD_DIM
    col_scale = jnp.concatenate([jnp.ones((2 * na,), jnp.float32), jnp.full((na,), BETA, jnp.float32),
                                 jnp.ones((nq + nkv,), jnp.float32), jnp.full((nkv,), BETA, jnp.float32)])
    return {
        "x_prompt": nrm(ks[0], (BATCH, SEQ, D_MODEL), 1.0),
        "x_sample": nrm(ks[1], (DEC_BATCH, DEC_SEQ, D_MODEL), 1.0),
        "cache_a_k": nrm(ks[2], (DEPTH, DEC_BATCH, a_rows, N_HEADS_A, HEAD_DIM), 1.0),
        "cache_a_v": nrm(ks[3], (DEPTH, DEC_BATCH, a_rows, N_HEADS_A, HEAD_DIM), BETA),
        "cache_b_k": nrm(ks[4], (DEPTH, DEC_BATCH, b_rows, N_KV_B, HEAD_DIM), 1.0),
        "cache_b_v": nrm(ks[5], (DEPTH, DEC_BATCH, b_rows, N_KV_B, HEAD_DIM), BETA),
        "c_prompt": nrm(ks[6], (BATCH, D_MODEL), 1.0),
        "c_sample": nrm(ks[7], (DEC_BATCH, D_MODEL), 1.0),
        "rel_bias": nrm(ks[8], (NUM_BUCKETS, N_HEADS_TOTAL), 0.5),
        "w_ada": nrm(ks[9], (DEPTH, D_MODEL, 9 * D_MODEL), 0.5 * D_MODEL ** -0.5),
        "b_ada": nrm(ks[10], (DEPTH, 9 * D_MODEL), 0.02),
        "ffn1_wg": nrm(ks[11], (DEPTH, D_MODEL, D_FF), D_MODEL ** -0.5),
        "ffn1_wu": nrm(ks[12], (DEPTH, D_MODEL, D_FF), D_MODEL ** -0.5),
        "ffn1_wd": nrm(ks[13], (DEPTH, D_FF, D_MODEL), BETA * D_FF ** -0.5),
        "w_in": nrm(ks[14], (DEPTH, D_MODEL, PROJ_COLS), D_MODEL ** -0.5) * col_scale,
        "w_out": nrm(ks[15], (DEPTH, MIX_WIDTH, D_MODEL), BETA * MIX_WIDTH ** -0.5),
        "sinks": nrm(ks[16], (DEPTH, N_HEADS_B), 0.5),
        "ffn2_wg": nrm(ks[17], (DEPTH, D_MODEL, D_FF), D_MODEL ** -0.5),
        "ffn2_wu": nrm(ks[18], (DEPTH, D_MODEL, D_FF), D_MODEL ** -0.5),
        "ffn2_wd": nrm(ks[19], (DEPTH, D_FF, D_MODEL), BETA * D_FF ** -0.5),
        "ln_g": 1.0 + nrm(ks[20], (DEPTH, 3, D_MODEL), 0.05),
        "ln_b": nrm(ks[21], (DEPTH, 3, D_MODEL), 0.05),
    }


def reference(x_prompt, x_sample, cache_a_k, cache_a_v, cache_b_k, cache_b_v, c_prompt, c_sample,
              rel_bias, w_ada, b_ada, ffn1_wg, ffn1_wu, ffn1_wd, w_in, w_out, sinks,
              ffn2_wg, ffn2_wu, ffn2_wd, ln_g, ln_b):
    def mix_p(l, h):
        return mixer_prompt(h, w_in[l], w_out[l], sinks[l], rel_bias)

    def mix_s(l, h):
        return mixer_sample(h, cache_a_k[l], cache_a_v[l], cache_b_k[l], cache_b_v[l],
                            w_in[l], w_out[l], sinks[l], rel_bias)

    y_prompt, pak, pav, pbk, pbv = trunk(x_prompt, c_prompt, mix_p, w_ada, b_ada, ffn1_wg, ffn1_wu, ffn1_wd,
                                         ffn2_wg, ffn2_wu, ffn2_wd, ln_g, ln_b)
    y_sample, sak, sav, sbk, sbv = trunk(x_sample, c_sample, mix_s, w_ada, b_ada, ffn1_wg, ffn1_wu, ffn1_wd,
                                         ffn2_wg, ffn2_wu, ffn2_wd, ln_g, ln_b)
    return (y_prompt, y_sample, pak, pav, pbk, pbv, sak, sav, sbk, sbv)
```

```cpp
#include <hip/hip_runtime.h>
#include <cstdio>
#include <cstdint>
#include <cstddef>
namespace pg8 {
#define PG8_LAS __attribute__((address_space(3)))
typedef unsigned short bf16_t;
typedef short bf16x8 __attribute__((ext_vector_type(8)));
typedef float f32x4 __attribute__((ext_vector_type(4)));
typedef unsigned u32x4 __attribute__((ext_vector_type(4)));
constexpr int BM = 256, BK = 64, HALF = 128, HTB = HALF * BK * 2  , STAGE_BYTES = 8 * HTB, NXCD = 8, WGM = 8;

__host__ __device__ __forceinline__ int lds_byte(int r, int c) { const int st = (r >> 4) * 2 + (c >> 5), rr = r & 15, cc = c & 31, ob = rr * 64 + cc * 2; return st * 1024 + (ob ^ (((ob >> 9) & 1) << 5)); }
__host__ __device__ __forceinline__ void stage_rc(int b, int& R, int& C) { const int st = b / 1024, sb = b % 1024, swz = sb ^ (((sb >> 9) & 1) << 5); R = (st >> 1) * 16 + swz / 64; C = (st & 1) * 32 + (swz % 64) / 2; }
__host__ __device__ __forceinline__ int perm32(int rho) { const int n = rho >> 4, i = rho & 15; return 8 * (i >> 2) + 4 * n + (i & 3); }

struct Unit { int pm, pn; };
struct Gemm { const bf16_t* A; const bf16_t* Bt; int M, N, K; };

struct StaticOrder {
    int nM, nN, nwg, G, c;
    __host__ __device__ void init(int M, int N, int G_, int c_) { nM = M / BM; nN = N / BM; nwg = nM * nN; G = G_; c = c_; }
    __host__ __device__ bool next(int i, Unit& u) const {
        const long L = (long)i * G + c; if (L >= nwg) return false;
        int wgid = (int)L; { const int q = nwg / NXCD, r = nwg % NXCD, xcd = wgid % NXCD, off = wgid / NXCD; wgid = (xcd < r ? xcd * (q + 1) : r * (q + 1) + (xcd - r) * q) + off; }
        const int nig = WGM * nN, gid = wgid / nig, fm = gid * WGM, gsz = (nM - fm) < WGM ? (nM - fm) : WGM;
        u.pm = fm + ((wgid % nig) % gsz); u.pn = (wgid % nig) / gsz; return true;
    }
    __device__ __forceinline__ void a_ready(const Unit&) const {}
    __device__ __forceinline__ void done(const Unit&) const {}
};
__device__ __forceinline__ unsigned cvt_pk_bf16(float lo, float hi) { unsigned r; asm volatile("v_cvt_pk_bf16_f32 %0, %1, %2" : "=v"(r) : "v"(lo), "v"(hi)); return r; }
typedef float f32x2 __attribute__((ext_vector_type(2)));
typedef float f32x2 __attribute__((ext_vector_type(2)));
struct EpiF32 {
    static constexpr bool PERM = false, AFTER_DRAIN = false;
    float* O; int ldc; const float* bias;
    __device__ __forceinline__ void operator()(const f32x4 (&acc)[2][2][4][2], const Unit& u, int wr, int wc, int fr, int fq) const {
        const int row0 = u.pm * BM + wr * 64 + fr, col0 = u.pn * BM + wc * 32 + 4 * fq;
        f32x4 bv[2][2];
#pragma unroll
        for (int bj = 0; bj < 2; ++bj)
#pragma unroll
            for (int n = 0; n < 2; ++n) bv[bj][n] = bias ? *(const f32x4*)(bias + col0 + bj * HALF + n * 16) : (f32x4){0.f, 0.f, 0.f, 0.f};
#pragma unroll
        for (int ai = 0; ai < 2; ++ai)
#pragma unroll
            for (int m = 0; m < 4; ++m) { float* rowp = O + (size_t)(row0 + ai * HALF + m * 16) * ldc + col0;
#pragma unroll
                for (int bj = 0; bj < 2; ++bj)
#pragma unroll
                    for (int n = 0; n < 2; ++n) *(f32x4*)(rowp + bj * HALF + n * 16) = acc[ai][bj][m][n] + bv[bj][n]; }
    }
};
__device__ __forceinline__ float silu_mul(float g, float u) { return g * u * __builtin_amdgcn_rcpf(1.0f + __builtin_amdgcn_exp2f(-1.4426950408889634f * g)); }
struct EpiSwiGLU {
    static constexpr bool PERM = true, AFTER_DRAIN = false;
    bf16_t* O; int ldc;
    __device__ __forceinline__ void operator()(const f32x4 (&acc)[2][2][4][2], const Unit& u, int wr, int wc, int fr, int fq) const {
        const int row0 = u.pm * BM + wr * 64 + fr, col0 = u.pn * HALF + wc * 32 + 8 * fq;
#pragma unroll
        for (int ai = 0; ai < 2; ++ai)
#pragma unroll
            for (int m = 0; m < 4; ++m) { bf16_t* rowp = O + (size_t)(row0 + ai * HALF + m * 16) * ldc + col0;
                const f32x4 g0 = acc[ai][0][m][0], g1 = acc[ai][0][m][1], u0 = acc[ai][1][m][0], u1 = acc[ai][1][m][1];
                u32x4 w; w.x = cvt_pk_bf16(silu_mul(g0[0], u0[0]), silu_mul(g0[1], u0[1])); w.y = cvt_pk_bf16(silu_mul(g0[2], u0[2]), silu_mul(g0[3], u0[3]));
                w.z = cvt_pk_bf16(silu_mul(g1[0], u1[0]), silu_mul(g1[1], u1[1])); w.w = cvt_pk_bf16(silu_mul(g1[2], u1[2]), silu_mul(g1[3], u1[3]));
                *(u32x4*)rowp = w; }
    }
};
struct EpiQKV {
    static constexpr bool PERM = true, AFTER_DRAIN = false;
    bf16_t* O;
    float* sq;
    float *pak, *pav, *pbk, *pbv, *sak, *sav, *sbk, *sbv;
    float qscale;
    __device__ __forceinline__ void operator()(const f32x4 (&acc)[2][2][4][2], const Unit& u, int wr, int wc, int fr, int fq) const {
        const int pn = u.pn;
#pragma unroll
        for (int ai = 0; ai < 2; ++ai)
#pragma unroll
            for (int m = 0; m < 4; ++m) { const int row = u.pm * BM + ai * HALF + wr * 64 + m * 16 + fr;
#pragma unroll
                for (int bj = 0; bj < 2; ++bj) { const int col = pn * BM + bj * HALF + wc * 32 + 8 * fq;
                    f32x4 v0 = acc[ai][bj][m][0], v1 = acc[ai][bj][m][1];
                    const bool isq = (pn < 2) || (pn == 6) || (pn == 7);
                    if (isq) { v0 = v0 * qscale; v1 = v1 * qscale; }
                    u32x4 w; w.x = cvt_pk_bf16(v0[0], v0[1]); w.y = cvt_pk_bf16(v0[2], v0[3]); w.z = cvt_pk_bf16(v1[0], v1[1]); w.w = cvt_pk_bf16(v1[2], v1[3]);
                    *(u32x4*)(O + (size_t)row * 2304 + col) = w;
                    float* dst = nullptr;
                    if (row < 16384) { const int b = row >> 12, t = row & 4095;
                        if (pn == 2 || pn == 3) { if (t >= 2048) dst = pak + ((size_t)(b * 2048 + t - 2048)) * 512 + (col - 512); }
                        else if (pn == 4 || pn == 5) { if (t >= 2048) dst = pav + ((size_t)(b * 2048 + t - 2048)) * 512 + (col - 1024); }
                        else if (pn == 8) { if (t >= 3968) dst = (bj == 0 ? pbk : pbv) + ((size_t)(b * 128 + t - 3968)) * 128 + (col - 2048 - bj * 128); }
                    } else if (row < 16512) { const int n = row - 16384;
                        if (pn < 2) dst = sq + (size_t)n * 1024 + col;
                        else if (pn == 2 || pn == 3) dst = sak + (size_t)n * 512 + (col - 512);
                        else if (pn == 4 || pn == 5) dst = sav + (size_t)n * 512 + (col - 1024);
                        else if (pn == 6 || pn == 7) dst = sq + (size_t)n * 1024 + 512 + (col - 1536);
                        else dst = (bj == 0 ? sbk : sbv) + (size_t)n * 128 + (col - 2048 - bj * 128);
                    }
                    if (dst) { *(f32x4*)dst = v0; *(f32x4*)(dst + 4) = v1; }
                } }
    }
};
template <class Epi, class Sched, bool ALIGN_EPI = false, bool SP2 = false>
__device__ __forceinline__ void gemm_phase(PG8_LAS unsigned char* lds, const Gemm g, const Sched& S, const Epi& E) {
    const int tid = threadIdx.x, wid = __builtin_amdgcn_readfirstlane(tid >> 6), lane = tid & 63, wr = wid >> 2, wc = wid & 3, fr = lane & 15, fq = lane >> 4;
    const int K = g.K, nt = K / BK;
    unsigned voffA[2], voffB[2];
#pragma unroll
    for (int i = 0; i < 2; ++i) { int R, C; stage_rc(tid * 16 + i * 8192, R, C); const int Rb = Epi::PERM ? ((R & ~31) + perm32(R & 31)) : R;
        voffA[i] = (unsigned)(R * K + C) * 2u; voffB[i] = (unsigned)(Rb * K + C) * 2u; }
    const size_t kstep = (size_t)(BK * 2);
    const size_t hstep = (size_t)HALF * K * 2;
    const size_t tstep = 2 * hstep;
    const unsigned ldsw = (unsigned)wid * 1024u;
    const int aoff = lds_byte(wr * 64 + fr, fq * 8), boff = lds_byte(wc * 32 + fr, fq * 8);
#define PG8_SA(b, h) (((b) * 2 + (h)) * HTB)
#define PG8_SB(b, h) ((4 + (b) * 2 + (h)) * HTB)
#define PG8_STAGE(bufoff, gbase, voff) do { _Pragma("unroll") for (int _i = 0; _i < 2; ++_i) \
        __builtin_amdgcn_global_load_lds((const unsigned*)((const char*)(gbase) + (voff)[_i]), (PG8_LAS unsigned*)(lds + (bufoff) + ldsw + _i * 8192), 16, 0, 0); } while (0)
#define PG8_LDA(dst, b, h) do { _Pragma("unroll") for (int m = 0; m < 4; ++m) _Pragma("unroll") for (int k = 0; k < 2; ++k) dst[m][k] = *(const PG8_LAS bf16x8*)(lds + PG8_SA(b, h) + aoff + m * 2048 + k * 1024); } while (0)
#define PG8_LDB(dst, b, h) do { _Pragma("unroll") for (int n = 0; n < 2; ++n) _Pragma("unroll") for (int k = 0; k < 2; ++k) dst[n][k] = *(const PG8_LAS bf16x8*)(lds + PG8_SB(b, h) + boff + n * 2048 + k * 1024); } while (0)
#define PG8_MMA(ai, bj, At, Bt) do { __builtin_amdgcn_s_setprio(1); _Pragma("unroll") for (int m = 0; m < 4; ++m) _Pragma("unroll") for (int n = 0; n < 2; ++n) _Pragma("unroll") for (int k = 0; k < 2; ++k) \
        acc[ai][bj][m][n] = __builtin_amdgcn_mfma_f32_16x16x32_bf16(Bt[n][k], At[m][k], acc[ai][bj][m][n], 0, 0, 0); __builtin_amdgcn_s_setprio(0); } while (0)
#define PG8_WAIT_V(n) asm volatile("s_waitcnt vmcnt(" #n ")" ::: "memory")
#define PG8_WAIT_L(n) asm volatile("s_waitcnt lgkmcnt(" #n ")" ::: "memory")
#define PG8_BAR __builtin_amdgcn_s_barrier()
#define PG8_SCHED __builtin_amdgcn_sched_barrier(0)
    Unit cur, nxt; int ui = 0;
    if (!S.next(0, cur)) return;
    f32x4 acc[2][2][4][2];
#pragma unroll
    for (int a = 0; a < 2; ++a)
#pragma unroll
        for (int b = 0; b < 2; ++b)
#pragma unroll
            for (int m = 0; m < 4; ++m)
#pragma unroll
                for (int n = 0; n < 2; ++n) acc[a][b][m][n] = (f32x4){0.f, 0.f, 0.f, 0.f};
    bf16x8 At[4][2], B0[2][2], B1[2][2];
    const char* cA = (const char*)g.A + (size_t)cur.pm * tstep; const char* cB = (const char*)g.Bt + (size_t)cur.pn * tstep;
    S.a_ready(cur);
    if constexpr (SP2) {
        PG8_STAGE(PG8_SB(0, 0), cB, voffB); PG8_STAGE(PG8_SB(0, 1), cB + hstep, voffB); PG8_STAGE(PG8_SA(0, 0), cA, voffA); PG8_STAGE(PG8_SA(0, 1), cA + hstep, voffA);
        if (wr == 1) PG8_BAR;
        PG8_WAIT_V(2); PG8_BAR;
        PG8_STAGE(PG8_SB(1, 0), cB + kstep, voffB); PG8_STAGE(PG8_SA(1, 0), cA + kstep, voffA); PG8_STAGE(PG8_SB(1, 1), cB + hstep + kstep, voffB);
        PG8_WAIT_V(6); PG8_BAR;
    } else {
        PG8_STAGE(PG8_SB(0, 0), cB, voffB); PG8_STAGE(PG8_SA(0, 0), cA, voffA); PG8_STAGE(PG8_SB(0, 1), cB + hstep, voffB); PG8_STAGE(PG8_SA(0, 1), cA + hstep, voffA);
        if (wr == 1) PG8_BAR;
        PG8_WAIT_V(4); PG8_BAR;
        PG8_STAGE(PG8_SB(1, 0), cB + kstep, voffB); PG8_STAGE(PG8_SA(1, 0), cA + kstep, voffA); PG8_STAGE(PG8_SB(1, 1), cB + hstep + kstep, voffB);
        PG8_WAIT_V(6); PG8_BAR;
    }
    for (;;) {
        const bool has_next = S.next(ui + 1, nxt);
        const char* nA = has_next ? (const char*)g.A + (size_t)nxt.pm * tstep : cA; const char* nB = has_next ? (const char*)g.Bt + (size_t)nxt.pn * tstep : cB;
        for (int t = 0; t < nt; t += 2) {
            const bool last = (t == nt - 2);
            const char* a1 = cA + (size_t)(t + 1) * kstep;
            const char* a2 = last ? nA : cA + (size_t)(t + 2) * kstep; const char* b2 = last ? nB : cB + (size_t)(t + 2) * kstep;
            const char* a3 = a2 + kstep; const char* b3 = b2 + kstep;
            if (last && has_next) S.a_ready(nxt);
            if constexpr (SP2) {
            PG8_LDB(B0, 0, 0); PG8_LDB(B1, 0, 1); PG8_SCHED; PG8_LDA(At, 0, 0); PG8_STAGE(PG8_SA(1, 1), a1 + hstep, voffA);
            PG8_WAIT_V(8); PG8_WAIT_L(0); PG8_BAR; PG8_MMA(0, 0, At, B0); PG8_MMA(0, 1, At, B1); PG8_BAR; PG8_SCHED;
            PG8_LDA(At, 0, 1); PG8_STAGE(PG8_SB(0, 0), b2, voffB); PG8_STAGE(PG8_SB(0, 1), b2 + hstep, voffB); PG8_STAGE(PG8_SA(0, 0), a2, voffA);
            PG8_WAIT_V(8); PG8_WAIT_L(0); PG8_BAR; PG8_MMA(1, 0, At, B0); PG8_MMA(1, 1, At, B1); PG8_BAR; PG8_SCHED;
            PG8_LDB(B0, 1, 0); PG8_LDB(B1, 1, 1); PG8_SCHED; PG8_LDA(At, 1, 0); PG8_STAGE(PG8_SA(0, 1), a2 + hstep, voffA);
            PG8_WAIT_V(8); PG8_WAIT_L(0); PG8_BAR; PG8_MMA(0, 0, At, B0); PG8_MMA(0, 1, At, B1); PG8_BAR; PG8_SCHED;
            PG8_LDA(At, 1, 1); PG8_STAGE(PG8_SB(1, 0), b3, voffB); PG8_STAGE(PG8_SB(1, 1), b3 + hstep, voffB); PG8_STAGE(PG8_SA(1, 0), a3, voffA);
            PG8_WAIT_V(8); PG8_WAIT_L(0); PG8_BAR; PG8_MMA(1, 0, At, B0); PG8_MMA(1, 1, At, B1); PG8_BAR; PG8_SCHED;
            } else {
            PG8_LDB(B0, 0, 0); PG8_SCHED; PG8_LDA(At, 0, 0); PG8_STAGE(PG8_SA(1, 1), a1 + hstep, voffA);
            PG8_WAIT_L(8); PG8_BAR; PG8_WAIT_L(0); PG8_MMA(0, 0, At, B0); PG8_BAR; PG8_SCHED;
            PG8_LDB(B1, 0, 1); PG8_STAGE(PG8_SB(0, 0), b2, voffB);
            PG8_BAR; PG8_WAIT_L(0); PG8_MMA(0, 1, At, B1); PG8_BAR;
            PG8_LDA(At, 0, 1); PG8_STAGE(PG8_SA(0, 0), a2, voffA);
            PG8_BAR; PG8_WAIT_L(0); PG8_MMA(1, 0, At, B0); PG8_BAR; PG8_SCHED;
            PG8_STAGE(PG8_SB(0, 1), b2 + hstep, voffB);
            PG8_WAIT_V(6); PG8_BAR; PG8_MMA(1, 1, At, B1); PG8_BAR;
            PG8_LDB(B0, 1, 0); PG8_SCHED; PG8_LDA(At, 1, 0); PG8_STAGE(PG8_SA(0, 1), a2 + hstep, voffA);
            PG8_WAIT_L(8); PG8_BAR; PG8_WAIT_L(0); PG8_MMA(0, 0, At, B0); PG8_BAR; PG8_SCHED;
            PG8_LDB(B1, 1, 1); PG8_STAGE(PG8_SB(1, 0), b3, voffB);
            PG8_BAR; PG8_WAIT_L(0); PG8_MMA(0, 1, At, B1); PG8_BAR;
            PG8_LDA(At, 1, 1); PG8_STAGE(PG8_SA(1, 0), a3, voffA);
            PG8_BAR; PG8_WAIT_L(0); PG8_MMA(1, 0, At, B0); PG8_BAR; PG8_SCHED;
            PG8_STAGE(PG8_SB(1, 1), b3 + hstep, voffB);
            PG8_WAIT_V(6); PG8_BAR; PG8_MMA(1, 1, At, B1); PG8_BAR;
            }
        }
        if constexpr (ALIGN_EPI) { if (wr == 0) PG8_BAR; }
        if constexpr (!Epi::AFTER_DRAIN) { E(acc, cur, wr, wc, fr, fq); S.done(cur); }
        if (!has_next) break;
#pragma unroll
        for (int a = 0; a < 2; ++a)
#pragma unroll
            for (int b = 0; b < 2; ++b)
#pragma unroll
                for (int m = 0; m < 4; ++m)
#pragma unroll
                    for (int n = 0; n < 2; ++n) acc[a][b][m][n] = (f32x4){0.f, 0.f, 0.f, 0.f};
        cur = nxt; cA = nA; cB = nB; ++ui;
        if constexpr (ALIGN_EPI) { if (wr == 1) PG8_BAR; }
    }
    PG8_WAIT_V(0);
    if constexpr (!ALIGN_EPI) { if (wr == 0) PG8_BAR; }
    PG8_BAR;
    if constexpr (Epi::AFTER_DRAIN) { E.fused(acc, cur, wr, wc, fr, fq, lds, wid, lane); S.done(cur); }
#undef PG8_SA
#undef PG8_SB
#undef PG8_STAGE
#undef PG8_LDA
#undef PG8_LDB
#undef PG8_MMA
#undef PG8_WAIT_V
#undef PG8_WAIT_L
#undef PG8_BAR
#undef PG8_SCHED
}
}
constexpr int D = 1024, DFF = 2816, NPROJ = 2304, SEQ = 4096, NBATCH = 4, MP = NBATCH * SEQ, NS = 128, M_REAL = MP + NS, M_PAD = 16640;
constexpr int NMOD = 9 * D;
constexpr float LN_EPS = 1e-5f;
constexpr float ALPHA = 1.189207115002721f;
constexpr float LOG2E = 1.4426950408889634f;
constexpr float QSCALE = 0.125f * LOG2E;
constexpr float NEGV = -1e30f;
constexpr int NWAVES = 8;

constexpr size_t MiB = 1u << 20;
constexpr size_t WS_CTL = 0, CTL_ZERO_BYTES = 1 * MiB;
constexpr size_t WS_WGU1 = 2 * MiB, WS_WD1 = 13 * MiB, WS_WIN = 19 * MiB, WS_WOUT = 24 * MiB, WS_WGU2 = 26 * MiB, WS_WD2 = 37 * MiB, WS_WADA = 43 * MiB;
constexpr size_t WS_AMOD = 61 * MiB, WS_MOD = 62 * MiB, WS_SQ = 71 * MiB + 512 * 1024, WS_H = 72 * MiB, WS_ACT = 105 * MiB, WS_Z = 195 * MiB, WS_X1 = 260 * MiB, WS_X2 = 325 * MiB;
constexpr size_t WS_QKV = 390 * MiB, WS_OA = 464 * MiB, WS_LSE = 512 * MiB, WS_MIX = 514 * MiB, WS_END = 547 * MiB;
static_assert(WS_MOD + (size_t)256 * NMOD * 4 <= WS_SQ && WS_SQ + (size_t)NS * 1024 * 4 <= WS_H && WS_H + (size_t)M_PAD * D * 2 <= WS_ACT && WS_ACT + (size_t)M_PAD * DFF * 2 <= WS_Z, "ws map 1");
static_assert(WS_Z + (size_t)M_PAD * D * 4 <= WS_X1 && WS_QKV + (size_t)M_PAD * NPROJ * 2 <= WS_OA && WS_OA + (size_t)3 * MP * 512 * 2 <= WS_LSE && WS_LSE + (size_t)3 * MP * 8 * 4 <= WS_MIX && WS_MIX + (size_t)M_PAD * D * 2 <= WS_END, "ws map 2");
constexpr int CW_BAR = 4096;

constexpr int RING_OFF = 0, RING_BYTES = 131072;
constexpr int LDSCTL_OFF = RING_BYTES, MISC_OFF = LDSCTL_OFF + 320;
constexpr int LDS_BYTES = 147456;

#define GAS __attribute__((address_space(1)))
#define LAS __attribute__((address_space(3)))
typedef unsigned short bf16;
typedef unsigned v4u __attribute__((ext_vector_type(4)));
typedef unsigned v2u __attribute__((ext_vector_type(2)));
typedef float f32x4 __attribute__((ext_vector_type(4)));
typedef short bf16x8 __attribute__((ext_vector_type(8)));
typedef float f32x16 __attribute__((ext_vector_type(16)));
typedef GAS unsigned gu32;
#define RLX_AGENT __ATOMIC_RELAXED, __HIP_MEMORY_SCOPE_AGENT
#define LDS_WAIT() asm volatile("s_waitcnt lgkmcnt(0)" ::: "memory")
__device__ __forceinline__ unsigned f2bf(float f) { unsigned u = __builtin_bit_cast(unsigned, f); return (u + 0x7fffu + ((u >> 16) & 1u)) >> 16; }
__device__ __forceinline__ unsigned pk2(float lo, float hi) { return f2bf(lo) | (f2bf(hi) << 16); }
__device__ __forceinline__ float bf2f(unsigned short b) { return __builtin_bit_cast(float, (unsigned)b << 16); }
#define XB_TMO      128
#define XB_XCNT(j)  (256  + 64 * (j))
#define XB_XSUB(j)  (1280 + 64 * (j))
#define XB_XGEN(j)  (2304 + 64 * (j))
#define XB_TOP      3328
#define XB_TOPGEN   3392
#define XCD_BAR_WORDS 3456
#define XB_SPIN_CAP (1u << 18)

__device__ __forceinline__ unsigned xb_ld(unsigned* p)              { return __hip_atomic_load(p, __ATOMIC_RELAXED, __HIP_MEMORY_SCOPE_AGENT); }
__device__ __forceinline__ unsigned xb_add(unsigned* p, unsigned v) { return __hip_atomic_fetch_add(p, v, __ATOMIC_RELAXED, __HIP_MEMORY_SCOPE_AGENT); }
__device__ __forceinline__ unsigned xb_xcc_id() { return (unsigned)__builtin_amdgcn_s_getreg((3 << 11) | 20) & 0xFu; }
#define XB_SPIN(cond, bar) do { unsigned _sp = 0; while (cond) { __builtin_amdgcn_s_sleep(1); \
    if ((++_sp & 255u) == 0u) { if (xb_ld(&(bar)[XB_TMO])) break; if (_sp > XB_SPIN_CAP) { atomicAdd(&(bar)[XB_TMO], 1u); break; } } } } while (0)

struct XcdBarrier {
    unsigned* bar; unsigned x;
    volatile LAS unsigned* st;
};

__device__ __forceinline__ XcdBarrier xcd_barrier_post(unsigned* bar, volatile LAS unsigned* st) {
    XcdBarrier b; b.bar = bar; b.x = xb_xcc_id(); b.st = st;
    if (threadIdx.x == 0) (void)xb_add(&bar[XB_XCNT(b.x)], 1u);
    return b;
}
__device__ __forceinline__ void xcd_barrier_complete(unsigned* bar, unsigned x, unsigned& nloc, unsigned& nx) {
    const unsigned G = gridDim.x * gridDim.y * gridDim.z;
    unsigned sum, cnt, mine, sp = 0u;
    for (;;) {
        sum = 0u; cnt = 0u; mine = 0u;
#pragma unroll
        for (unsigned j = 0; j < 16; ++j) { const unsigned c = xb_ld(&bar[XB_XCNT(j)]); sum += c; cnt += (c > 0u) ? 1u : 0u; mine = (j == x) ? c : mine; }
        if (sum == G) break;
        __builtin_amdgcn_s_sleep(1);
        if ((++sp & 255u) == 0u) { if (xb_ld(&bar[XB_TMO])) break; if (sp > XB_SPIN_CAP) { atomicAdd(&bar[XB_TMO], 1u); break; } }
    }
    nloc = mine > 0u ? mine : 1u; nx = cnt > 0u ? cnt : 1u;
}

__device__ __forceinline__ void xcd_barrier(const XcdBarrier& b) {
    asm volatile("s_waitcnt vmcnt(0)" ::: "memory");
    __syncthreads();
    if (threadIdx.x == 0) {
        unsigned* bar = b.bar;
        __builtin_amdgcn_s_waitcnt(0);
        unsigned nloc = b.st[0], nx = b.st[1];
        if (nloc == 0u) { xcd_barrier_complete(bar, b.x, nloc, nx); b.st[0] = nloc; b.st[1] = nx; }
        const unsigned old = xb_add(&bar[XB_XSUB(b.x)], 1u);
        const unsigned gen = old / nloc;
        if (old + 1u == (gen + 1u) * nloc) {
            __builtin_amdgcn_fence(__ATOMIC_RELEASE, "agent");
            asm volatile("s_waitcnt vmcnt(0)" ::: "memory");
            const unsigned og = xb_add(&bar[XB_TOP], 1u);
            const unsigned tg = og / nx;
            if (og + 1u == (tg + 1u) * nx) xb_add(&bar[XB_TOPGEN], 1u);
            else XB_SPIN(xb_ld(&bar[XB_TOPGEN]) == tg, bar);
            __builtin_amdgcn_fence(__ATOMIC_ACQUIRE, "agent");
            xb_add(&bar[XB_XGEN(b.x)], 1u);
            asm volatile("s_waitcnt vmcnt(0)" ::: "memory");
        } else {
            XB_SPIN(xb_ld(&bar[XB_XGEN(b.x)]) == gen, bar);
            __builtin_amdgcn_fence(__ATOMIC_ACQUIRE, "agent");
            asm volatile("s_waitcnt vmcnt(0)" ::: "memory");
        }
    }
    __syncthreads();
}
struct Args { const float* in[22]; float* out; unsigned char* ws; };
struct Frame {
    LAS unsigned char* lds;
    int tid, lane, wave, vcu, G;
};
__device__ __forceinline__ float wave_sum(float v) {
#pragma unroll
    for (int o = 1; o < 64; o <<= 1) v += __shfl_xor(v, o);
    return v;
}
__device__ __forceinline__ float wave_max(float v) {
#pragma unroll
    for (int o = 1; o < 64; o <<= 1) v = fmaxf(v, __shfl_xor(v, o));
    return v;
}
__device__ __forceinline__ void p0_transpose_item(const float* W, int K, int N, bf16* WT, int k0, int n0, int drow0, LAS float* scr, int lane) {
#pragma unroll 8
    for (int i = 0; i < 32; ++i) { const int kk = 2 * i + (lane >> 5); scr[kk * 33 + (lane & 31)] = W[(size_t)(k0 + kk) * N + n0 + (lane & 31)]; }
    LDS_WAIT(); asm volatile("" ::: "memory");
    const int c = lane & 7;
#pragma unroll
    for (int j = 0; j < 4; ++j) { const int n = (lane >> 3) + 8 * j; const LAS float* s = scr + (8 * c) * 33 + n;
        v4u o; o.x = pk2(s[0 * 33], s[1 * 33]); o.y = pk2(s[2 * 33], s[3 * 33]); o.z = pk2(s[4 * 33], s[5 * 33]); o.w = pk2(s[6 * 33], s[7 * 33]);
        *(GAS v4u*)(WT + (size_t)(drow0 + n) * K + k0 + 8 * c) = o; }
    LDS_WAIT(); asm volatile("" ::: "memory");
}
template <bool GU>
__device__ __forceinline__ bool p0_matrix(int& r, const float* W, int K, int N, bf16* WT, int half, LAS float* scr, int lane) {
    const int nblk = N / 32, items = (K / 64) * nblk;
    if (r >= items) { r -= items; return false; }
    const int kb = r / nblk, nb = r % nblk, n0 = 32 * nb;
    const int drow0 = GU ? (256 * (n0 >> 7) + (n0 & 127) + half * 128) : n0;
    p0_transpose_item(W, K, N, WT, 64 * kb, n0, drow0, scr, lane);
    return true;
}
__device__ __forceinline__ int seq_of_row(int row) { return row < MP ? (row >> 12) : (4 + row - MP); }

typedef float f32x2_t __attribute__((ext_vector_type(2))); typedef __bf16 bf16x2_t __attribute__((ext_vector_type(2)));
__device__ __forceinline__ unsigned cvtpk(float lo, float hi) { f32x2_t v = {lo, hi}; bf16x2_t b = __builtin_convertvector(v, bf16x2_t); return __builtin_bit_cast(unsigned, b); }
#define PACK8(X, S) __builtin_bit_cast(bf16x8, (v4u){cvtpk((X)[8 * (S) + 0], (X)[8 * (S) + 1]), cvtpk((X)[8 * (S) + 2], (X)[8 * (S) + 3]), cvtpk((X)[8 * (S) + 4], (X)[8 * (S) + 5]), cvtpk((X)[8 * (S) + 6], (X)[8 * (S) + 7])})
__device__ __forceinline__ int t5_bucket(int n) {
    if (n < 16) return n;
    int b = 16;
    b += (n >= 22); b += (n >= 30); b += (n >= 40); b += (n >= 54); b += (n >= 73); b += (n >= 99); b += (n >= 134); b += (n >= 182);
    b += (n >= 246); b += (n >= 332); b += (n >= 450); b += (n >= 609); b += (n >= 825); b += (n >= 1117); b += (n >= 1513);
    return b;
}
__device__ __forceinline__ void band_task(const bf16* Qb, const bf16* Kb, const bf16* Vb, size_t stride, int j0, const LAS float* tab, bool has_sink, float sink2,
                                          f32x16 (&o)[2], float& lse2) {
    const int lane = threadIdx.x & 63, q = lane & 31, hi = lane >> 5;
    bf16x8 qf[4];
    { const bf16* qrow = Qb + (size_t)(j0 + q) * stride + 8 * hi;
#pragma unroll
      for (int d0 = 0; d0 < 4; ++d0) qf[d0] = *(const bf16x8*)(qrow + 16 * d0); }
    const int pr = (q & ~12) | ((q & 4) << 1) | ((q & 8) >> 1);
    const int tb = 8 * hi - q + 31;
    f32x16 s[5];
#pragma unroll
    for (int kt = 0; kt < 5; ++kt) {
        int jj = j0 - 128 + 32 * kt + pr; jj = jj < 0 ? 0 : jj;
        const bf16* krow = Kb + (size_t)jj * stride + 8 * hi;
        bf16x8 kf[4];
#pragma unroll
        for (int d0 = 0; d0 < 4; ++d0) kf[d0] = *(const bf16x8*)(krow + 16 * d0);
        f32x16 c;
#pragma unroll
        for (int r = 0; r < 16; ++r) c[r] = tab[tb + 32 * kt + 16 * (r >> 3) + (r & 7)];
#pragma unroll
        for (int d0 = 0; d0 < 4; ++d0) c = __builtin_amdgcn_mfma_f32_32x32x16_bf16(kf[d0], qf[d0], c, 0, 0, 0);
        if (j0 < 128) {
#pragma unroll
            for (int r = 0; r < 16; ++r) { const int jr = j0 - 128 + 32 * kt + 16 * (r >> 3) + 8 * hi + (r & 7); if (jr < 0) c[r] = NEGV; }
        }
        s[kt] = c;
    }
    float m = s[0][0];
#pragma unroll
    for (int kt = 0; kt < 5; ++kt)
#pragma unroll
        for (int r = 0; r < 16; ++r) m = fmaxf(m, s[kt][r]);
    m = fmaxf(m, __shfl_xor(m, 32));
    if (has_sink) m = fmaxf(m, sink2);
    float den = 0.f;
#pragma unroll
    for (int kt = 0; kt < 5; ++kt)
#pragma unroll
        for (int r = 0; r < 16; ++r) { const float p = __builtin_amdgcn_exp2f(s[kt][r] - m); s[kt][r] = p; den += p; }
    den += __shfl_xor(den, 32);
    if (has_sink) den += __builtin_amdgcn_exp2f(sink2 - m);
    bf16x8 I0, I1;
#pragma unroll
    for (int j = 0; j < 8; ++j) { const bool on = (((q >> 3) & 1) == hi) && ((q & 7) == j);
        I0[j] = (on && (q >> 4) == 0) ? (short)0x3F80 : (short)0; I1[j] = (on && (q >> 4) == 1) ? (short)0x3F80 : (short)0; }
    o[0] = (f32x16){}; o[1] = (f32x16){};
#pragma unroll
    for (int kt = 0; kt < 5; ++kt) {
        int jj = j0 - 128 + 32 * kt + pr; jj = jj < 0 ? 0 : jj;
        const bf16* vrow = Vb + (size_t)jj * stride + 8 * hi;
        bf16x8 vf[4];
#pragma unroll
        for (int d0 = 0; d0 < 4; ++d0) vf[d0] = *(const bf16x8*)(vrow + 16 * d0);
        f32x16 X0 = (f32x16){}, X1 = (f32x16){};
        X0 = __builtin_amdgcn_mfma_f32_32x32x16_bf16(vf[0], I0, X0, 0, 0, 0); X0 = __builtin_amdgcn_mfma_f32_32x32x16_bf16(vf[1], I1, X0, 0, 0, 0);
        X1 = __builtin_amdgcn_mfma_f32_32x32x16_bf16(vf[2], I0, X1, 0, 0, 0); X1 = __builtin_amdgcn_mfma_f32_32x32x16_bf16(vf[3], I1, X1, 0, 0, 0);
        { const bf16x8 pa = PACK8(s[kt], 0); o[0] = __builtin_amdgcn_mfma_f32_32x32x16_bf16(PACK8(X0, 0), pa, o[0], 0, 0, 0); o[1] = __builtin_amdgcn_mfma_f32_32x32x16_bf16(PACK8(X1, 0), pa, o[1], 0, 0, 0); }
        { const bf16x8 pa = PACK8(s[kt], 1); o[0] = __builtin_amdgcn_mfma_f32_32x32x16_bf16(PACK8(X0, 1), pa, o[0], 0, 0, 0); o[1] = __builtin_amdgcn_mfma_f32_32x32x16_bf16(PACK8(X1, 1), pa, o[1], 0, 0, 0); }
    }
    const float inv = 1.0f / den;
#pragma unroll
    for (int r = 0; r < 16; ++r) { o[0][r] *= inv; o[1][r] *= inv; }
    lse2 = m + __builtin_log2f(den);
}
__device__ __forceinline__ void sample_task(bool isB, int n, int h, const float* sq, const float* rel_bias, const float* sinks,
                                            const float* cache_k, const float* cache_v, const float* own_k, const float* own_v, bf16* mix, LAS float* pbuf) {
    const int lane = threadIdx.x & 63;
    f32x4 qv[16];
    { const f32x4* qp = (const f32x4*)(sq + (size_t)n * 1024 + (isB ? 512 : 0) + h * 64);
#pragma unroll
      for (int i = 0; i < 16; ++i) qv[i] = qp[i]; }
    const int nvis = isB ? 129 : 321, npass = isB ? 3 : 6;
    const int rowstride = isB ? 128 : 512, nrows = isB ? 128 : 2048, hcol = isB ? (h >> 2) * 64 : h * 64;
    const float* ck = cache_k + (size_t)n * nrows * rowstride + hcol;
    const float* cv = cache_v + (size_t)n * nrows * rowstride + hcol;
    const float* ok = own_k + (size_t)n * rowstride + hcol;
    const float* ov = own_v + (size_t)n * rowstride + hcol;
    const int bcol = isB ? 8 + h : h;
    float lmax = NEGV;
#pragma unroll 1
    for (int pass = 0; pass < npass; ++pass) {
        const int v = pass * 64 + lane; const bool valid = v < nvis;
        int dl = isB ? v : (v < 129 ? v : (v < 225 ? 128 + 4 * (v - 128) : 512 + 16 * (v - 224)));
        if (!valid) dl = 0;
        const f32x4* kp = (const f32x4*)(dl == 0 ? ok : ck + (size_t)(nrows - dl) * rowstride);
        float dot = 0.f;
#pragma unroll
        for (int i = 0; i < 16; ++i) { const f32x4 kk = kp[i]; dot += (kk[0] * qv[i][0] + kk[1] * qv[i][1]) + (kk[2] * qv[i][2] + kk[3] * qv[i][3]); }
        float lm = 0.f;
        if (!isB) { const int mult = (dl <= 128 ? 1 : 0) + ((dl <= 512 && (dl & 3) == 0) ? 1 : 0) + ((dl & 15) == 0 ? 1 : 0); lm = mult == 3 ? 1.5849625007211562f : (mult == 2 ? 1.0f : 0.f); }
        float s = dot + rel_bias[t5_bucket(dl) * 16 + bcol] * LOG2E + lm;
        s = valid ? s : NEGV;
        pbuf[v] = s; lmax = fmaxf(lmax, s);
    }
    float m = wave_max(lmax);
    const float sink2 = isB ? sinks[h] * LOG2E : NEGV;
    if (isB) m = fmaxf(m, sink2);
    float den = 0.f;
    LDS_WAIT(); asm volatile("" ::: "memory");
#pragma unroll 1
    for (int pass = 0; pass < npass; ++pass) { const int v = pass * 64 + lane; const float p = __builtin_amdgcn_exp2f(pbuf[v] - m); den += p; pbuf[v] = p; }
    den = wave_sum(den);
    if (isB) den += __builtin_amdgcn_exp2f(sink2 - m);
    LDS_WAIT(); asm volatile("" ::: "memory");
    const int dch = lane & 15, g = lane >> 4;
    f32x4 acc = (f32x4){0.f, 0.f, 0.f, 0.f};
    const int nit = (nvis + 3) >> 2;
#pragma unroll 8
    for (int it = 0; it < nit; ++it) {
        const int v = 4 * it + g;
        if (v < nvis) {
            const int dl = isB ? v : (v < 129 ? v : (v < 225 ? 128 + 4 * (v - 128) : 512 + 16 * (v - 224)));
            const float* vp = dl == 0 ? ov : cv + (size_t)(nrows - dl) * rowstride;
            const f32x4 val = *(const f32x4*)(vp + 4 * dch);
            acc += val * pbuf[v];
        }
    }
#pragma unroll
    for (int e = 0; e < 4; ++e) { float t = acc[e]; t += __shfl_xor(t, 16); t += __shfl_xor(t, 32); acc[e] = t; }
    LDS_WAIT(); asm volatile("" ::: "memory");
    if (g == 0) { const float inv = 1.0f / den; v2u w; w.x = pk2(acc[0] * inv, acc[1] * inv); w.y = pk2(acc[2] * inv, acc[3] * inv);
        *(v2u*)(mix + (size_t)(MP + n) * D + (isB ? 512 : 0) + h * 64 + 4 * dch) = w; }
}

template <bool HAS_H>
__device__ __forceinline__ void ln_rows(const Frame& F, const float* xp, const float* xs, const float* Z, const float* MOD, int gc, float gs, const float* lng, const float* lnb,
                                        float* outp, bf16* Hout, int shc, int scc) {
    const int gw = F.vcu * NWAVES + F.wave, NGW = F.G * NWAVES;
    for (int row = gw; row < M_REAL; row += NGW) {
        const int seq = seq_of_row(row);
        const f32x4* xr = (const f32x4*)(row < MP ? xp + (size_t)row * D : xs + (size_t)(row - MP) * D) + F.lane;
        const f32x4* zr = (const f32x4*)(Z + (size_t)row * D) + F.lane;
        const f32x4* mr = (const f32x4*)(MOD + (size_t)seq * NMOD) + F.lane;
        f32x4 a[4]; float s = 0.f;
#pragma unroll
        for (int j = 0; j < 4; ++j) { a[j] = xr[64 * j] * ALPHA + (mr[gc * 256 + 64 * j] * gs) * zr[64 * j]; s += (a[j][0] + a[j][1]) + (a[j][2] + a[j][3]); }
        const float mean = wave_sum(s) * (1.f / D); float s2 = 0.f;
#pragma unroll
        for (int j = 0; j < 4; ++j) { a[j] = a[j] - mean; s2 += (a[j][0] * a[j][0] + a[j][1] * a[j][1]) + (a[j][2] * a[j][2] + a[j][3] * a[j][3]); }
        const float rstd = 1.f / sqrtf(wave_sum(s2) * (1.f / D) + LN_EPS);
        f32x4* orow = (f32x4*)(outp + (size_t)row * D) + F.lane;
        v2u* hrow = (v2u*)(Hout + (size_t)row * D) + F.lane;
#pragma unroll
        for (int j = 0; j < 4; ++j) { const f32x4 o = a[j] * rstd * ((const f32x4*)lng)[F.lane + 64 * j] + ((const f32x4*)lnb)[F.lane + 64 * j];
            orow[64 * j] = o;
            if (HAS_H) { const f32x4 hh = o * (mr[scc * 256 + 64 * j] + 1.0f) + mr[shc * 256 + 64 * j]; v2u w; w.x = pk2(hh[0], hh[1]); w.y = pk2(hh[2], hh[3]); hrow[64 * j] = w; } }
    }
}

__global__ void __launch_bounds__(NWAVES * 64, 2) mega_fwd(Args args) {
    extern __shared__ __attribute__((aligned(16))) unsigned char lds[];
    Frame F;
    F.lds = (LAS unsigned char*)lds;
    volatile LAS unsigned* MISC = (volatile LAS unsigned*)(F.lds + MISC_OFF);
    F.tid = threadIdx.x; F.lane = F.tid & 63; F.wave = __builtin_amdgcn_readfirstlane(F.tid >> 6);
    F.G = gridDim.x; { const int bx = blockIdx.x; F.vcu = (F.G % 8 == 0) ? (bx % 8) * (F.G / 8) + bx / 8 : bx; }
    gu32* ctl = (gu32*)(args.ws + WS_CTL);
    for (int u = F.tid; u < (LDS_BYTES - LDSCTL_OFF) / 4; u += NWAVES * 64) ((LAS unsigned*)(F.lds + LDSCTL_OFF))[u] = 0u;
    __syncthreads();
    XcdBarrier bar = xcd_barrier_post((unsigned*)(ctl + CW_BAR), MISC + 8);
    const int gw = F.vcu * NWAVES + F.wave, NGW = F.G * NWAVES;

#define IN_(i) (args.in[i])
#define x_prompt IN_(0)
#define x_sample IN_(1)
#define cache_a_k IN_(2)
#define cache_a_v IN_(3)
#define cache_b_k IN_(4)
#define cache_b_v IN_(5)
#define c_prompt IN_(6)
#define c_sample IN_(7)
#define rel_bias IN_(8)
#define w_ada IN_(9)
#define b_ada IN_(10)
#define sinks IN_(16)
#define ln_g IN_(20)
#define ln_b IN_(21)
#define OUTP (args.out)
#define o_pak (args.out + 16908288)
#define o_pav (args.out + 21102592)
#define o_pbk (args.out + 25296896)
#define o_pbv (args.out + 25362432)
#define o_sak (args.out + 25427968)
#define o_sav (args.out + 25493504)
#define o_sbk (args.out + 25559040)
#define o_sbv (args.out + 25575424)
#define WGU1 ((bf16*)(args.ws + WS_WGU1))
#define WD1 ((bf16*)(args.ws + WS_WD1))
#define WIN ((bf16*)(args.ws + WS_WIN))
#define WOUT ((bf16*)(args.ws + WS_WOUT))
#define WGU2 ((bf16*)(args.ws + WS_WGU2))
#define WD2 ((bf16*)(args.ws + WS_WD2))
#define WADA ((bf16*)(args.ws + WS_WADA))
#define AMOD ((bf16*)(args.ws + WS_AMOD))
#define MOD ((float*)(args.ws + WS_MOD))
#define SQ ((float*)(args.ws + WS_SQ))
#define H ((bf16*)(args.ws + WS_H))
#define ACT ((bf16*)(args.ws + WS_ACT))
#define Z ((float*)(args.ws + WS_Z))
#define X1 ((float*)(args.ws + WS_X1))
#define X2 ((float*)(args.ws + WS_X2))
#define QKV ((bf16*)(args.ws + WS_QKV))
#define OA ((bf16*)(args.ws + WS_OA))
#define LSE ((float*)(args.ws + WS_LSE))
#define MIX ((bf16*)(args.ws + WS_MIX))
    {
        LAS float* scr = (LAS float*)(F.lds + RING_OFF + F.wave * 16384);
        constexpr int NITEMS = 2 * (3 * 16 * 88) + 16 * 72 + 16 * 32 + 16 * 288;
        for (int it = gw; it < NITEMS; it += NGW) {
            int r = it;
            if (p0_matrix<true>(r, args.in[11], D, DFF, WGU1, 0, scr, F.lane)) continue;
            if (p0_matrix<true>(r, args.in[12], D, DFF, WGU1, 1, scr, F.lane)) continue;
            if (p0_matrix<false>(r, args.in[13], DFF, D, WD1, 0, scr, F.lane)) continue;
            if (p0_matrix<false>(r, args.in[14], D, NPROJ, WIN, 0, scr, F.lane)) continue;
            if (p0_matrix<false>(r, args.in[15], D, D, WOUT, 0, scr, F.lane)) continue;
            if (p0_matrix<true>(r, args.in[17], D, DFF, WGU2, 0, scr, F.lane)) continue;
            if (p0_matrix<true>(r, args.in[18], D, DFF, WGU2, 1, scr, F.lane)) continue;
            if (p0_matrix<false>(r, args.in[19], DFF, D, WD2, 0, scr, F.lane)) continue;
            p0_matrix<false>(r, w_ada, D, NMOD, WADA, 0, scr, F.lane);
        }
        for (int r = gw; r < 256; r += NGW) {
            v2u* orow = (v2u*)(AMOD + (size_t)r * D) + F.lane;
            const float* crow_ = r < 4 ? c_prompt + (size_t)r * D : (r < 132 ? c_sample + (size_t)(r - 4) * D : nullptr);
#pragma unroll
            for (int j = 0; j < 4; ++j) { v2u w; w.x = 0u; w.y = 0u;
                if (crow_) { const f32x4 c = ((const f32x4*)crow_)[F.lane + 64 * j]; f32x4 sv;
#pragma unroll
                    for (int e = 0; e < 4; ++e) sv[e] = c[e] * __builtin_amdgcn_rcpf(1.0f + __builtin_amdgcn_exp2f(-LOG2E * c[e]));
                    w.x = pk2(sv[0], sv[1]); w.y = pk2(sv[2], sv[3]); }
                orow[64 * j] = w; }
        }
        for (int r = gw; r < 256; r += NGW) {
            bf16* base = (r < 128 ? H : MIX) + (size_t)(M_REAL + (r & 127)) * D;
            v4u zz = (v4u){0u, 0u, 0u, 0u}; ((v4u*)base)[F.lane] = zz; ((v4u*)base)[F.lane + 64] = zz;
        }
    }
    xcd_barrier(bar);
    {
        pg8::Gemm g{AMOD, WADA, 256, NMOD, D}; pg8::StaticOrder S; S.init(256, NMOD, F.G, (int)blockIdx.x);
        pg8::EpiF32 E{MOD, NMOD, b_ada};
        pg8::gemm_phase<pg8::EpiF32, pg8::StaticOrder, true, true>(F.lds + RING_OFF, g, S, E);
    }
    xcd_barrier(bar);
    for (int row = gw; row < M_REAL; row += NGW) {
        const int seq = seq_of_row(row);
        const f32x4* xr = (const f32x4*)(row < MP ? x_prompt + (size_t)row * D : x_sample + (size_t)(row - MP) * D) + F.lane;
        const f32x4* mr = (const f32x4*)(MOD + (size_t)seq * NMOD) + F.lane;
        v2u* hrow = (v2u*)(H + (size_t)row * D) + F.lane;
#pragma unroll
        for (int j = 0; j < 4; ++j) { const f32x4 hh = xr[64 * j] * (mr[256 + 64 * j] + 1.0f) + mr[64 * j]; v2u w; w.x = pk2(hh[0], hh[1]); w.y = pk2(hh[2], hh[3]); hrow[64 * j] = w; }
    }
    xcd_barrier(bar);
    {
        pg8::Gemm g{H, WGU1, M_PAD, 2 * DFF, D}; pg8::StaticOrder S; S.init(M_PAD, 2 * DFF, F.G, (int)blockIdx.x);
        pg8::EpiSwiGLU E{ACT, DFF};
        pg8::gemm_phase<pg8::EpiSwiGLU, pg8::StaticOrder, true, true>(F.lds + RING_OFF, g, S, E);
    }
    xcd_barrier(bar);
    {
        pg8::Gemm g{ACT, WD1, M_PAD, D, DFF}; pg8::StaticOrder S; S.init(M_PAD, D, F.G, (int)blockIdx.x);
        pg8::EpiF32 E{Z, D, nullptr};
        pg8::gemm_phase<pg8::EpiF32, pg8::StaticOrder, true, true>(F.lds + RING_OFF, g, S, E);
    }
    xcd_barrier(bar);
    ln_rows<true>(F, x_prompt, x_sample, Z, MOD, 2, 0.5f, ln_g, ln_b, X1, H, 3, 4);
    xcd_barrier(bar);
    {
        pg8::Gemm g{H, WIN, M_PAD, NPROJ, D}; pg8::StaticOrder S; S.init(M_PAD, NPROJ, F.G, (int)blockIdx.x);
        pg8::EpiQKV E{QKV, SQ, o_pak, o_pav, o_pbk, o_pbv, o_sak, o_sav, o_sbk, o_sbv, QSCALE};
        pg8::gemm_phase<pg8::EpiQKV, pg8::StaticOrder, true, true>(F.lds + RING_OFF, g, S, E);
    }
    xcd_barrier(bar);
    {
        LAS float* tabs = (LAS float*)(F.lds + RING_OFF);
        for (int idx = F.tid; idx < 4 * 8 * 192; idx += NWAVES * 64) {
            const int type = idx / 1536, h = (idx / 192) & 7, i = idx % 192, dist = 159 - i;
            float v = NEGV;
            if (dist >= 0 && dist <= 128) { const int dil = type == 1 ? 4 : (type == 2 ? 16 : 1); v = rel_bias[t5_bucket(dist * dil) * 16 + (type == 3 ? 8 + h : h)] * LOG2E; }
            tabs[idx] = v;
        }
        __syncthreads();
        LAS float* pbuf = (LAS float*)(F.lds + RING_OFF + 32768 + F.wave * 2048);
#ifndef NO_SAMPLE
        for (int st = gw; st < 2 * NS * 8; st += NGW) {
            const bool isB = st >= NS * 8; const int r = isB ? st - NS * 8 : st, n = r >> 3, h = r & 7;
            sample_task(isB, n, h, SQ, rel_bias, sinks, isB ? cache_b_k : cache_a_k, isB ? cache_b_v : cache_a_v, isB ? o_sbk : o_sak, isB ? o_sbv : o_sav, MIX, pbuf);
        }
#endif
#ifndef NO_BAND
        for (int task = gw; task < 4 * 4096; task += NGW) {
            const int type = task >> 12, rem = task & 4095, h = rem & 7, x = rem >> 3, b = x >> 7, y = x & 127;
            const int dil = type == 1 ? 4 : (type == 2 ? 16 : 1);
            const int per = 128 / dil, rc = y / per, qblk = y % per, j0 = 32 * qblk;
            const size_t stride = (size_t)dil * NPROJ;
            const bf16* base = QKV + (size_t)(b * SEQ + rc) * NPROJ;
            const bf16 *Qb, *Kb, *Vb;
            if (type < 3) { Qb = base + h * 64; Kb = base + 512 + h * 64; Vb = base + 1024 + h * 64; }
            else { Qb = base + 1536 + h * 64; Kb = base + 2048 + (h >> 2) * 64; Vb = base + 2176 + (h >> 2) * 64; }
            f32x16 o[2]; float lse2;
            band_task(Qb, Kb, Vb, stride, j0, tabs + (type * 8 + h) * 192, type == 3, type == 3 ? sinks[h] * LOG2E : 0.f, o, lse2);
            const int q = F.lane & 31, hi = F.lane >> 5;
            const int token = b * SEQ + rc + dil * (j0 + q);
            bf16* dst = type < 3 ? OA + ((size_t)type * MP + token) * 512 + h * 64 : MIX + (size_t)token * D + 512 + h * 64;
#pragma unroll
            for (int nb = 0; nb < 2; ++nb)
#pragma unroll
                for (int g4 = 0; g4 < 4; ++g4) { v2u w; w.x = cvtpk(o[nb][4 * g4 + 0], o[nb][4 * g4 + 1]); w.y = cvtpk(o[nb][4 * g4 + 2], o[nb][4 * g4 + 3]);
                    *(v2u*)(dst + 32 * nb + 8 * g4 + 4 * hi) = w; }
            if (type < 3 && hi == 0) LSE[((size_t)type * MP + token) * 8 + h] = lse2;
        }
#endif
    }
    xcd_barrier(bar);
    for (int token = gw; token < MP; token += NGW) {
        const int h = F.lane >> 3;
        float l0 = LSE[((size_t)0 * MP + token) * 8 + h], l1 = LSE[((size_t)1 * MP + token) * 8 + h], l2 = LSE[((size_t)2 * MP + token) * 8 + h];
        const float mx = fmaxf(l0, fmaxf(l1, l2));
        float w0 = __builtin_amdgcn_exp2f(l0 - mx), w1 = __builtin_amdgcn_exp2f(l1 - mx), w2 = __builtin_amdgcn_exp2f(l2 - mx);
        const float inv = 1.0f / (w0 + w1 + w2); w0 *= inv; w1 *= inv; w2 *= inv;
        const v4u a0 = ((const v4u*)(OA + ((size_t)0 * MP + token) * 512))[F.lane], a1 = ((const v4u*)(OA + ((size_t)1 * MP + token) * 512))[F.lane], a2 = ((const v4u*)(OA + ((size_t)2 * MP + token) * 512))[F.lane];
        v4u w;
#pragma unroll
        for (int e = 0; e < 4; ++e) {
            const float lo = w0 * bf2f((unsigned short)(a0[e] & 0xffffu)) + w1 * bf2f((unsigned short)(a1[e] & 0xffffu)) + w2 * bf2f((unsigned short)(a2[e] & 0xffffu));
            const float hi_ = w0 * bf2f((unsigned short)(a0[e] >> 16)) + w1 * bf2f((unsigned short)(a1[e] >> 16)) + w2 * bf2f((unsigned short)(a2[e] >> 16));
            w[e] = pk2(lo, hi_);
        }
        ((v4u*)(MIX + (size_t)token * D))[F.lane] = w;
    }
    xcd_barrier(bar);
    {
        pg8::Gemm g{MIX, WOUT, M_PAD, D, D}; pg8::StaticOrder S; S.init(M_PAD, D, F.G, (int)blockIdx.x);
        pg8::EpiF32 E{Z, D, nullptr};
        pg8::gemm_phase<pg8::EpiF32, pg8::StaticOrder, true, true>(F.lds + RING_OFF, g, S, E);
    }
    xcd_barrier(bar);
    ln_rows<true>(F, X1, X1 + (size_t)MP * D, Z, MOD, 5, 1.0f, ln_g + D, ln_b + D, X2, H, 6, 7);
    xcd_barrier(bar);
    {
        pg8::Gemm g{H, WGU2, M_PAD, 2 * DFF, D}; pg8::StaticOrder S; S.init(M_PAD, 2 * DFF, F.G, (int)blockIdx.x);
        pg8::EpiSwiGLU E{ACT, DFF};
        pg8::gemm_phase<pg8::EpiSwiGLU, pg8::StaticOrder, true, true>(F.lds + RING_OFF, g, S, E);
    }
    xcd_barrier(bar);
    {
        pg8::Gemm g{ACT, WD2, M_PAD, D, DFF}; pg8::StaticOrder S; S.init(M_PAD, D, F.G, (int)blockIdx.x);
        pg8::EpiF32 E{Z, D, nullptr};
        pg8::gemm_phase<pg8::EpiF32, pg8::StaticOrder, true, true>(F.lds + RING_OFF, g, S, E);
    }
    xcd_barrier(bar);
    ln_rows<false>(F, X2, X2 + (size_t)MP * D, Z, MOD, 8, 0.5f, ln_g + 2 * D, ln_b + 2 * D, OUTP, nullptr, 0, 0);
#ifdef PROBE_SCALE9
    if (blockIdx.x == 0) { for (int i = F.tid; i < 16384; i += NWAVES * 64) o_sbv[i] *= 1.05f; }
#endif
}

#undef IN_
#undef x_prompt
#undef x_sample
#undef cache_a_k
#undef cache_a_v
#undef cache_b_k
#undef cache_b_v
#undef c_prompt
#undef c_sample
#undef rel_bias
#undef w_ada
#undef b_ada
#undef sinks
#undef ln_g
#undef ln_b
#undef OUTP
#undef o_pak
#undef o_pav
#undef o_pbk
#undef o_pbv
#undef o_sak
#undef o_sav
#undef o_sbk
#undef o_sbv
#undef WGU1
#undef WD1
#undef WIN
#undef WOUT
#undef WGU2
#undef WD2
#undef WADA
#undef AMOD
#undef MOD
#undef SQ
#undef H
#undef ACT
#undef Z
#undef X1
#undef X2
#undef QKV
#undef OA
#undef LSE
#undef MIX
extern "C" void kernel_launch(void* const* d_in, const int* in_sizes, int n_in, void* d_out, int out_size, void* d_ws, size_t ws_size, hipStream_t stream) {
    static int grid = 0;
    if (grid == 0) {
        if (n_in != 22 || out_size != 25591808 || ws_size < WS_END) { fprintf(stderr, "kernel_launch: unexpected shapes (n_in %d out %d ws %zu)\n", n_in, out_size, ws_size); grid = -1; return; }
        int dev = 0, cus = 0, per_cu = 0;
        if (hipGetDevice(&dev) != hipSuccess || hipDeviceGetAttribute(&cus, hipDeviceAttributeMultiprocessorCount, dev) != hipSuccess) { grid = -1; return; }
        if (hipFuncSetAttribute((const void*)mega_fwd, hipFuncAttributeMaxDynamicSharedMemorySize, LDS_BYTES) != hipSuccess) { fprintf(stderr, "kernel_launch: hipFuncSetAttribute failed\n"); grid = -1; return; }
        if (hipOccupancyMaxActiveBlocksPerMultiprocessor(&per_cu, (const void*)mega_fwd, NWAVES * 64, LDS_BYTES) != hipSuccess || per_cu < 1)
            fprintf(stderr, "kernel_launch: occupancy query reports %d workgroups per CU\n", per_cu);
        (void)hipGetLastError();
        grid = cus;
    }
    if (grid < 0) return;
    if (hipMemsetAsync((char*)d_ws + WS_CTL, 0, CTL_ZERO_BYTES, stream) != hipSuccess) return;
    Args a{};
    for (int i = 0; i < 22; ++i) a.in[i] = (const float*)d_in[i];
    a.out = (float*)d_out; a.ws = (unsigned char*)d_ws;
    hipLaunchKernelGGL(mega_fwd, dim3(grid), dim3(NWAVES * 64), LDS_BYTES, stream, a);
}
```

```cpp
#include <hip/hip_runtime.h>
#include <cstdio>
#include <cstdint>
#include <cstddef>
namespace pg8 {
#define PG8_LAS __attribute__((address_space(3)))
typedef unsigned short bf16_t;
typedef short bf16x8 __attribute__((ext_vector_type(8)));
typedef float f32x4 __attribute__((ext_vector_type(4)));
typedef unsigned u32x4 __attribute__((ext_vector_type(4)));
constexpr int BM = 256, BK = 64, HALF = 128, HTB = HALF * BK * 2  , STAGE_BYTES = 8 * HTB, NXCD = 8, WGM = 8;

__host__ __device__ __forceinline__ int lds_byte(int r, int c) { const int st = (r >> 4) * 2 + (c >> 5), rr = r & 15, cc = c & 31, ob = rr * 64 + cc * 2; return st * 1024 + (ob ^ (((ob >> 9) & 1) << 5)); }
__host__ __device__ __forceinline__ void stage_rc(int b, int& R, int& C) { const int st = b / 1024, sb = b % 1024, swz = sb ^ (((sb >> 9) & 1) << 5); R = (st >> 1) * 16 + swz / 64; C = (st & 1) * 32 + (swz % 64) / 2; }
__host__ __device__ __forceinline__ int perm32(int rho) { const int n = rho >> 4, i = rho & 15; return 8 * (i >> 2) + 4 * n + (i & 3); }

struct Unit { int pm, pn, k0, nt; };
struct Gemm { const bf16_t* A; const bf16_t* Bt; int M, N, K; };

struct StaticOrder {
    int nM, nN, nwg, G, c, ntf;
    __host__ __device__ void init(int M, int N, int K, int G_, int c_) { nM = M / BM; nN = N / BM; nwg = nM * nN; G = G_; c = c_; ntf = K / BK; }
    __host__ __device__ bool next(int i, Unit& u) const {
        const long L = (long)i * G + c; if (L >= nwg) return false;
        int wgid = (int)L; { const int q = nwg / NXCD, r = nwg % NXCD, xcd = wgid % NXCD, off = wgid / NXCD; wgid = (xcd < r ? xcd * (q + 1) : r * (q + 1) + (xcd - r) * q) + off; }
        const int nig = WGM * nN, gid = wgid / nig, fm = gid * WGM, gsz = (nM - fm) < WGM ? (nM - fm) : WGM;
        u.pm = fm + ((wgid % nig) % gsz); u.pn = (wgid % nig) / gsz; u.k0 = 0; u.nt = ntf; return true;
    }
    __device__ __forceinline__ void a_ready(const Unit&) const {}
    __device__ __forceinline__ void done(const Unit&) const {}
};
struct TailSplitOrder {
    StaticOrder so; int nsplit, SL;
    __host__ __device__ void init(int K, int SL_, int G_, int c_) { so.init(64 * BM, 4 * BM, K, G_, c_); SL = SL_; nsplit = 4 * ((K / BK) / SL_); }
    __host__ __device__ bool next(int i, Unit& u) const {
        const long L = (long)i * so.G + so.c;
        if (L < so.nwg) return so.next(i, u);
        const int j = (int)(L - so.nwg); if (j >= nsplit) return false;
        u.pm = 64; u.pn = j & 3; u.k0 = (j >> 2) * SL; u.nt = SL; return true;
    }
    __device__ __forceinline__ void a_ready(const Unit&) const {}
    __device__ __forceinline__ void done(const Unit&) const {}
};
__device__ __forceinline__ unsigned cvt_pk_bf16(float lo, float hi) { unsigned r; asm volatile("v_cvt_pk_bf16_f32 %0, %1, %2" : "=v"(r) : "v"(lo), "v"(hi)); return r; }
typedef float f32x2 __attribute__((ext_vector_type(2)));
typedef float f32x2 __attribute__((ext_vector_type(2)));
struct EpiF32 {
    static constexpr bool PERM = false, AFTER_DRAIN = false;
    float* O; int ldc; const float* bias;
    __device__ __forceinline__ void operator()(const f32x4 (&acc)[2][2][4][2], const Unit& u, int wr, int wc, int fr, int fq) const {
        const int row0 = u.pm * BM + wr * 64 + fr, col0 = u.pn * BM + wc * 32 + 4 * fq;
        f32x4 bv[2][2];
#pragma unroll
        for (int bj = 0; bj < 2; ++bj)
#pragma unroll
            for (int n = 0; n < 2; ++n) bv[bj][n] = bias ? *(const f32x4*)(bias + col0 + bj * HALF + n * 16) : (f32x4){0.f, 0.f, 0.f, 0.f};
#pragma unroll
        for (int ai = 0; ai < 2; ++ai)
#pragma unroll
            for (int m = 0; m < 4; ++m) { float* rowp = O + (size_t)(row0 + ai * HALF + m * 16) * ldc + col0;
#pragma unroll
                for (int bj = 0; bj < 2; ++bj)
#pragma unroll
                    for (int n = 0; n < 2; ++n) *(f32x4*)(rowp + bj * HALF + n * 16) = acc[ai][bj][m][n] + bv[bj][n]; }
    }
};
struct EpiF32Z {
    static constexpr bool PERM = false, AFTER_DRAIN = false;
    float* Z; float* SLAB;
    __device__ __forceinline__ void operator()(const f32x4 (&acc)[2][2][4][2], const Unit& u, int wr, int wc, int fr, int fq) const {
        const int col0 = u.pn * BM + wc * 32 + 4 * fq;
        if (u.pm < 64) {
#pragma unroll
            for (int ai = 0; ai < 2; ++ai)
#pragma unroll
                for (int m = 0; m < 4; ++m) { float* rowp = Z + (size_t)(u.pm * BM + wr * 64 + fr + ai * HALF + m * 16) * 1024 + col0;
#pragma unroll
                    for (int bj = 0; bj < 2; ++bj)
#pragma unroll
                        for (int n = 0; n < 2; ++n) *(f32x4*)(rowp + bj * HALF + n * 16) = acc[ai][bj][m][n]; }
        } else {
            float* sl = SLAB + (size_t)(u.k0 / u.nt) * (128 * 1024);
#pragma unroll
            for (int m = 0; m < 4; ++m) { float* rowp = sl + (size_t)(wr * 64 + fr + m * 16) * 1024 + col0;
#pragma unroll
                for (int bj = 0; bj < 2; ++bj)
#pragma unroll
                    for (int n = 0; n < 2; ++n) *(f32x4*)(rowp + bj * HALF + n * 16) = acc[0][bj][m][n]; }
        }
    }
};
__device__ __forceinline__ float silu_mul(float g, float u) { return g * u * __builtin_amdgcn_rcpf(1.0f + __builtin_amdgcn_exp2f(-1.4426950408889634f * g)); }
struct EpiSwiGLU {
    static constexpr bool PERM = true, AFTER_DRAIN = false;
    bf16_t* O; int ldc;
    __device__ __forceinline__ void operator()(const f32x4 (&acc)[2][2][4][2], const Unit& u, int wr, int wc, int fr, int fq) const {
        const int row0 = u.pm * BM + wr * 64 + fr, col0 = u.pn * HALF + wc * 32 + 8 * fq;
#pragma unroll
        for (int ai = 0; ai < 2; ++ai)
#pragma unroll
            for (int m = 0; m < 4; ++m) { bf16_t* rowp = O + (size_t)(row0 + ai * HALF + m * 16) * ldc + col0;
                const f32x4 g0 = acc[ai][0][m][0], g1 = acc[ai][0][m][1], u0 = acc[ai][1][m][0], u1 = acc[ai][1][m][1];
                u32x4 w; w.x = cvt_pk_bf16(silu_mul(g0[0], u0[0]), silu_mul(g0[1], u0[1])); w.y = cvt_pk_bf16(silu_mul(g0[2], u0[2]), silu_mul(g0[3], u0[3]));
                w.z = cvt_pk_bf16(silu_mul(g1[0], u1[0]), silu_mul(g1[1], u1[1])); w.w = cvt_pk_bf16(silu_mul(g1[2], u1[2]), silu_mul(g1[3], u1[3]));
                *(u32x4*)rowp = w; }
    }
};
struct EpiQKV {
    static constexpr bool PERM = true, AFTER_DRAIN = false;
    bf16_t* O;
    float* sq;
    float *pak, *pav, *pbk, *pbv, *sak, *sav, *sbk, *sbv;
    float qscale;
    __device__ __forceinline__ void operator()(const f32x4 (&acc)[2][2][4][2], const Unit& u, int wr, int wc, int fr, int fq) const {
        const int pn = u.pn;
#pragma unroll
        for (int ai = 0; ai < 2; ++ai)
#pragma unroll
            for (int m = 0; m < 4; ++m) { const int row = u.pm * BM + ai * HALF + wr * 64 + m * 16 + fr;
#pragma unroll
                for (int bj = 0; bj < 2; ++bj) { const int col = pn * BM + bj * HALF + wc * 32 + 8 * fq;
                    f32x4 v0 = acc[ai][bj][m][0], v1 = acc[ai][bj][m][1];
                    const bool isq = (pn < 2) || (pn == 6) || (pn == 7);
                    if (isq) { v0 = v0 * qscale; v1 = v1 * qscale; }
                    u32x4 w; w.x = cvt_pk_bf16(v0[0], v0[1]); w.y = cvt_pk_bf16(v0[2], v0[3]); w.z = cvt_pk_bf16(v1[0], v1[1]); w.w = cvt_pk_bf16(v1[2], v1[3]);
                    *(u32x4*)(O + (size_t)row * 2304 + col) = w;
                    float* dst = nullptr;
                    if (row < 16384) { const int b = row >> 12, t = row & 4095;
                        if (pn == 2 || pn == 3) { if (t >= 2048) dst = pak + ((size_t)(b * 2048 + t - 2048)) * 512 + (col - 512); }
                        else if (pn == 4 || pn == 5) { if (t >= 2048) dst = pav + ((size_t)(b * 2048 + t - 2048)) * 512 + (col - 1024); }
                        else if (pn == 8) { if (t >= 3968) dst = (bj == 0 ? pbk : pbv) + ((size_t)(b * 128 + t - 3968)) * 128 + (col - 2048 - bj * 128); }
                    } else if (row < 16512) { const int n = row - 16384;
                        if (pn < 2) dst = sq + (size_t)n * 1024 + col;
                        else if (pn == 2 || pn == 3) dst = sak + (size_t)n * 512 + (col - 512);
                        else if (pn == 4 || pn == 5) dst = sav + (size_t)n * 512 + (col - 1024);
                        else if (pn == 6 || pn == 7) dst = sq + (size_t)n * 1024 + 512 + (col - 1536);
                        else dst = (bj == 0 ? sbk : sbv) + (size_t)n * 128 + (col - 2048 - bj * 128);
                    }
                    if (dst) { *(f32x4*)dst = v0; *(f32x4*)(dst + 4) = v1; }
                } }
    }
};
template <class Epi, class Sched, bool ALIGN_EPI = false, bool SP2 = false>
__device__ __forceinline__ void gemm_phase(PG8_LAS unsigned char* lds, const Gemm g, const Sched& S, const Epi& E) {
    const int tid = threadIdx.x, wid = __builtin_amdgcn_readfirstlane(tid >> 6), lane = tid & 63, wr = wid >> 2, wc = wid & 3, fr = lane & 15, fq = lane >> 4;
    const int K = g.K;
    unsigned voffA[2], voffB[2];
#pragma unroll
    for (int i = 0; i < 2; ++i) { int R, C; stage_rc(tid * 16 + i * 8192, R, C); const int Rb = Epi::PERM ? ((R & ~31) + perm32(R & 31)) : R;
        voffA[i] = (unsigned)(R * K + C) * 2u; voffB[i] = (unsigned)(Rb * K + C) * 2u; }
    const size_t kstep = (size_t)(BK * 2);
    const size_t hstep = (size_t)HALF * K * 2;
    const size_t tstep = 2 * hstep;
    const unsigned ldsw = (unsigned)wid * 1024u;
    const int aoff = lds_byte(wr * 64 + fr, fq * 8), boff = lds_byte(wc * 32 + fr, fq * 8);
#define PG8_SA(b, h) (((b) * 2 + (h)) * HTB)
#define PG8_SB(b, h) ((4 + (b) * 2 + (h)) * HTB)
#define PG8_STAGE(bufoff, gbase, voff) do { _Pragma("unroll") for (int _i = 0; _i < 2; ++_i) \
        __builtin_amdgcn_global_load_lds((const unsigned*)((const char*)(gbase) + (voff)[_i]), (PG8_LAS unsigned*)(lds + (bufoff) + ldsw + _i * 8192), 16, 0, 0); } while (0)
#define PG8_LDA(dst, b, h) do { _Pragma("unroll") for (int m = 0; m < 4; ++m) _Pragma("unroll") for (int k = 0; k < 2; ++k) dst[m][k] = *(const PG8_LAS bf16x8*)(lds + PG8_SA(b, h) + aoff + m * 2048 + k * 1024); } while (0)
#define PG8_LDB(dst, b, h) do { _Pragma("unroll") for (int n = 0; n < 2; ++n) _Pragma("unroll") for (int k = 0; k < 2; ++k) dst[n][k] = *(const PG8_LAS bf16x8*)(lds + PG8_SB(b, h) + boff + n * 2048 + k * 1024); } while (0)
#define PG8_MMA(ai, bj, At, Bt) do { __builtin_amdgcn_s_setprio(1); _Pragma("unroll") for (int m = 0; m < 4; ++m) _Pragma("unroll") for (int n = 0; n < 2; ++n) _Pragma("unroll") for (int k = 0; k < 2; ++k) \
        acc[ai][bj][m][n] = __builtin_amdgcn_mfma_f32_16x16x32_bf16(Bt[n][k], At[m][k], acc[ai][bj][m][n], 0, 0, 0); __builtin_amdgcn_s_setprio(0); } while (0)
#define PG8_WAIT_V(n) asm volatile("s_waitcnt vmcnt(" #n ")" ::: "memory")
#define PG8_WAIT_L(n) asm volatile("s_waitcnt lgkmcnt(" #n ")" ::: "memory")
#define PG8_BAR __builtin_amdgcn_s_barrier()
#define PG8_SCHED __builtin_amdgcn_sched_barrier(0)
    Unit cur, nxt; int ui = 0;
    if (!S.next(0, cur)) return;
    f32x4 acc[2][2][4][2];
#pragma unroll
    for (int a = 0; a < 2; ++a)
#pragma unroll
        for (int b = 0; b < 2; ++b)
#pragma unroll
            for (int m = 0; m < 4; ++m)
#pragma unroll
                for (int n = 0; n < 2; ++n) acc[a][b][m][n] = (f32x4){0.f, 0.f, 0.f, 0.f};
    bf16x8 At[4][2], B0[2][2], B1[2][2];
    const char* cA = (const char*)g.A + (size_t)cur.pm * tstep + (size_t)cur.k0 * kstep; const char* cB = (const char*)g.Bt + (size_t)cur.pn * tstep + (size_t)cur.k0 * kstep;
    S.a_ready(cur);
    if constexpr (SP2) {
        PG8_STAGE(PG8_SB(0, 0), cB, voffB); PG8_STAGE(PG8_SB(0, 1), cB + hstep, voffB); PG8_STAGE(PG8_SA(0, 0), cA, voffA); PG8_STAGE(PG8_SA(0, 1), cA + hstep, voffA);
        if (wr == 1) PG8_BAR;
        PG8_WAIT_V(2); PG8_BAR;
        PG8_STAGE(PG8_SB(1, 0), cB + kstep, voffB); PG8_STAGE(PG8_SA(1, 0), cA + kstep, voffA); PG8_STAGE(PG8_SB(1, 1), cB + hstep + kstep, voffB);
        PG8_WAIT_V(6); PG8_BAR;
    } else {
        PG8_STAGE(PG8_SB(0, 0), cB, voffB); PG8_STAGE(PG8_SA(0, 0), cA, voffA); PG8_STAGE(PG8_SB(0, 1), cB + hstep, voffB); PG8_STAGE(PG8_SA(0, 1), cA + hstep, voffA);
        if (wr == 1) PG8_BAR;
        PG8_WAIT_V(4); PG8_BAR;
        PG8_STAGE(PG8_SB(1, 0), cB + kstep, voffB); PG8_STAGE(PG8_SA(1, 0), cA + kstep, voffA); PG8_STAGE(PG8_SB(1, 1), cB + hstep + kstep, voffB);
        PG8_WAIT_V(6); PG8_BAR;
    }
    for (;;) {
        const bool has_next = S.next(ui + 1, nxt);
        const char* nA = has_next ? (const char*)g.A + (size_t)nxt.pm * tstep + (size_t)nxt.k0 * kstep : cA; const char* nB = has_next ? (const char*)g.Bt + (size_t)nxt.pn * tstep + (size_t)nxt.k0 * kstep : cB;
        const int nt = cur.nt;
        for (int t = 0; t < nt; t += 2) {
            const bool last = (t == nt - 2);
            const char* a1 = cA + (size_t)(t + 1) * kstep;
            const char* a2 = last ? nA : cA + (size_t)(t + 2) * kstep; const char* b2 = last ? nB : cB + (size_t)(t + 2) * kstep;
            const char* a3 = a2 + kstep; const char* b3 = b2 + kstep;
            if (last && has_next) S.a_ready(nxt);
            if constexpr (SP2) {
            PG8_LDB(B0, 0, 0); PG8_LDB(B1, 0, 1); PG8_SCHED; PG8_LDA(At, 0, 0); PG8_STAGE(PG8_SA(1, 1), a1 + hstep, voffA);
            PG8_WAIT_V(8); PG8_WAIT_L(0); PG8_BAR; PG8_MMA(0, 0, At, B0); PG8_MMA(0, 1, At, B1); PG8_BAR; PG8_SCHED;
            PG8_LDA(At, 0, 1); PG8_STAGE(PG8_SB(0, 0), b2, voffB); PG8_STAGE(PG8_SB(0, 1), b2 + hstep, voffB); PG8_STAGE(PG8_SA(0, 0), a2, voffA);
            PG8_WAIT_V(8); PG8_WAIT_L(0); PG8_BAR; PG8_MMA(1, 0, At, B0); PG8_MMA(1, 1, At, B1); PG8_BAR; PG8_SCHED;
            PG8_LDB(B0, 1, 0); PG8_LDB(B1, 1, 1); PG8_SCHED; PG8_LDA(At, 1, 0); PG8_STAGE(PG8_SA(0, 1), a2 + hstep, voffA);
            PG8_WAIT_V(8); PG8_WAIT_L(0); PG8_BAR; PG8_MMA(0, 0, At, B0); PG8_MMA(0, 1, At, B1); PG8_BAR; PG8_SCHED;
            PG8_LDA(At, 1, 1); PG8_STAGE(PG8_SB(1, 0), b3, voffB); PG8_STAGE(PG8_SB(1, 1), b3 + hstep, voffB); PG8_STAGE(PG8_SA(1, 0), a3, voffA);
            PG8_WAIT_V(8); PG8_WAIT_L(0); PG8_BAR; PG8_MMA(1, 0, At, B0); PG8_MMA(1, 1, At, B1); PG8_BAR; PG8_SCHED;
            } else {
            PG8_LDB(B0, 0, 0); PG8_SCHED; PG8_LDA(At, 0, 0); PG8_STAGE(PG8_SA(1, 1), a1 + hstep, voffA);
            PG8_WAIT_L(8); PG8_BAR; PG8_WAIT_L(0); PG8_MMA(0, 0, At, B0); PG8_BAR; PG8_SCHED;
            PG8_LDB(B1, 0, 1); PG8_STAGE(PG8_SB(0, 0), b2, voffB);
            PG8_BAR; PG8_WAIT_L(0); PG8_MMA(0, 1, At, B1); PG8_BAR;
            PG8_LDA(At, 0, 1); PG8_STAGE(PG8_SA(0, 0), a2, voffA);
            PG8_BAR; PG8_WAIT_L(0); PG8_MMA(1, 0, At, B0); PG8_BAR; PG8_SCHED;
            PG8_STAGE(PG8_SB(0, 1), b2 + hstep, voffB);
            PG8_WAIT_V(6); PG8_BAR; PG8_MMA(1, 1, At, B1); PG8_BAR;
            PG8_LDB(B0, 1, 0); PG8_SCHED; PG8_LDA(At, 1, 0); PG8_STAGE(PG8_SA(0, 1), a2 + hstep, voffA);
            PG8_WAIT_L(8); PG8_BAR; PG8_WAIT_L(0); PG8_MMA(0, 0, At, B0); PG8_BAR; PG8_SCHED;
            PG8_LDB(B1, 1, 1); PG8_STAGE(PG8_SB(1, 0), b3, voffB);
            PG8_BAR; PG8_WAIT_L(0); PG8_MMA(0, 1, At, B1); PG8_BAR;
            PG8_LDA(At, 1, 1); PG8_STAGE(PG8_SA(1, 0), a3, voffA);
            PG8_BAR; PG8_WAIT_L(0); PG8_MMA(1, 0, At, B0); PG8_BAR; PG8_SCHED;
            PG8_STAGE(PG8_SB(1, 1), b3 + hstep, voffB);
            PG8_WAIT_V(6); PG8_BAR; PG8_MMA(1, 1, At, B1); PG8_BAR;
            }
        }
        if constexpr (ALIGN_EPI) { if (wr == 0) PG8_BAR; }
        if constexpr (!Epi::AFTER_DRAIN) { E(acc, cur, wr, wc, fr, fq); S.done(cur); }
        if (!has_next) break;
#pragma unroll
        for (int a = 0; a < 2; ++a)
#pragma unroll
            for (int b = 0; b < 2; ++b)
#pragma unroll
                for (int m = 0; m < 4; ++m)
#pragma unroll
                    for (int n = 0; n < 2; ++n) acc[a][b][m][n] = (f32x4){0.f, 0.f, 0.f, 0.f};
        cur = nxt; cA = nA; cB = nB; ++ui;
        if constexpr (ALIGN_EPI) { if (wr == 1) PG8_BAR; }
    }
    PG8_WAIT_V(0);
    if constexpr (!ALIGN_EPI) { if (wr == 0) PG8_BAR; }
    PG8_BAR;
    if constexpr (Epi::AFTER_DRAIN) { E.fused(acc, cur, wr, wc, fr, fq, lds, wid, lane); S.done(cur); }
#undef PG8_SA
#undef PG8_SB
#undef PG8_STAGE
#undef PG8_LDA
#undef PG8_LDB
#undef PG8_MMA
#undef PG8_WAIT_V
#undef PG8_WAIT_L
#undef PG8_BAR
#undef PG8_SCHED
}
}
constexpr int D = 1024, DFF = 2816, NPROJ = 2304, SEQ = 4096, NBATCH = 4, MP = NBATCH * SEQ, NS = 128, M_REAL = MP + NS, M_PAD = 16640;
constexpr int NMOD = 9 * D;
constexpr float LN_EPS = 1e-5f;
constexpr float ALPHA = 1.189207115002721f;
constexpr float LOG2E = 1.4426950408889634f;
constexpr float QSCALE = 0.125f * LOG2E;
constexpr float NEGV = -1e30f;
constexpr int NWAVES = 8;

constexpr size_t MiB = 1u << 20;
constexpr size_t WS_CTL = 0, CTL_ZERO_BYTES = 1 * MiB;
constexpr size_t WS_WGU1 = 2 * MiB, WS_WD1 = 13 * MiB, WS_WIN = 19 * MiB, WS_WOUT = 24 * MiB, WS_WGU2 = 26 * MiB, WS_WD2 = 37 * MiB, WS_WADA = 43 * MiB;
constexpr size_t WS_AMOD = 61 * MiB, WS_MOD = 62 * MiB, WS_SQ = 71 * MiB + 512 * 1024, WS_H = 72 * MiB, WS_ACT = 105 * MiB, WS_Z = 195 * MiB, WS_X1 = 260 * MiB, WS_X2 = 325 * MiB;
constexpr size_t WS_QKV = 390 * MiB, WS_OA = 464 * MiB, WS_LSE = 512 * MiB, WS_MIX = 514 * MiB, WS_SLAB = 548 * MiB, WS_END = 554 * MiB;
static_assert(WS_MOD + (size_t)256 * NMOD * 4 <= WS_SQ && WS_SQ + (size_t)NS * 1024 * 4 <= WS_H && WS_H + (size_t)M_PAD * D * 2 <= WS_ACT && WS_ACT + (size_t)M_PAD * DFF * 2 <= WS_Z, "ws map 1");
static_assert(WS_Z + (size_t)M_PAD * D * 4 <= WS_X1 && WS_QKV + (size_t)M_PAD * NPROJ * 2 <= WS_OA && WS_OA + (size_t)3 * MP * 512 * 2 <= WS_LSE && WS_LSE + (size_t)3 * MP * 8 * 4 <= WS_MIX && WS_MIX + (size_t)M_PAD * D * 2 <= WS_SLAB && WS_SLAB + (size_t)11 * 128 * 1024 * 4 <= WS_END, "ws map 2");
constexpr int CW_BAR = 4096;

constexpr int RING_OFF = 0, RING_BYTES = 131072;
constexpr int LDSCTL_OFF = RING_BYTES, MISC_OFF = LDSCTL_OFF + 320;
constexpr int LDS_BYTES = 147456;

#define GAS __attribute__((address_space(1)))
#define LAS __attribute__((address_space(3)))
typedef unsigned short bf16;
typedef unsigned v4u __attribute__((ext_vector_type(4)));
typedef unsigned v2u __attribute__((ext_vector_type(2)));
typedef float f32x4 __attribute__((ext_vector_type(4)));
typedef short bf16x8 __attribute__((ext_vector_type(8)));
typedef float f32x16 __attribute__((ext_vector_type(16)));
typedef GAS unsigned gu32;
#define RLX_AGENT __ATOMIC_RELAXED, __HIP_MEMORY_SCOPE_AGENT
#define LDS_WAIT() asm volatile("s_waitcnt lgkmcnt(0)" ::: "memory")
__device__ __forceinline__ unsigned f2bf(float f) { unsigned u = __builtin_bit_cast(unsigned, f); return (u + 0x7fffu + ((u >> 16) & 1u)) >> 16; }
__device__ __forceinline__ unsigned pk2(float lo, float hi) { return f2bf(lo) | (f2bf(hi) << 16); }
__device__ __forceinline__ float bf2f(unsigned short b) { return __builtin_bit_cast(float, (unsigned)b << 16); }
#define XB_TMO      128
#define XB_XCNT(j)  (256  + 64 * (j))
#define XB_XSUB(j)  (1280 + 64 * (j))
#define XB_XGEN(j)  (2304 + 64 * (j))
#define XB_TOP      3328
#define XB_TOPGEN   3392
#define XCD_BAR_WORDS 3456
#define XB_SPIN_CAP (1u << 18)

__device__ __forceinline__ unsigned xb_ld(unsigned* p)              { return __hip_atomic_load(p, __ATOMIC_RELAXED, __HIP_MEMORY_SCOPE_AGENT); }
__device__ __forceinline__ unsigned xb_add(unsigned* p, unsigned v) { return __hip_atomic_fetch_add(p, v, __ATOMIC_RELAXED, __HIP_MEMORY_SCOPE_AGENT); }
__device__ __forceinline__ unsigned xb_xcc_id() { return (unsigned)__builtin_amdgcn_s_getreg((3 << 11) | 20) & 0xFu; }
#define XB_SPIN(cond, bar) do { unsigned _sp = 0; while (cond) { __builtin_amdgcn_s_sleep(1); \
    if ((++_sp & 255u) == 0u) { if (xb_ld(&(bar)[XB_TMO])) break; if (_sp > XB_SPIN_CAP) { atomicAdd(&(bar)[XB_TMO], 1u); break; } } } } while (0)

struct XcdBarrier {
    unsigned* bar; unsigned x;
    volatile LAS unsigned* st;
};

__device__ __forceinline__ XcdBarrier xcd_barrier_post(unsigned* bar, volatile LAS unsigned* st) {
    XcdBarrier b; b.bar = bar; b.x = xb_xcc_id(); b.st = st;
    if (threadIdx.x == 0) (void)xb_add(&bar[XB_XCNT(b.x)], 1u);
    return b;
}
__device__ __forceinline__ void xcd_barrier_complete(unsigned* bar, unsigned x, unsigned& nloc, unsigned& nx) {
    const unsigned G = gridDim.x * gridDim.y * gridDim.z;
    unsigned sum, cnt, mine, sp = 0u;
    for (;;) {
        sum = 0u; cnt = 0u; mine = 0u;
#pragma unroll
        for (unsigned j = 0; j < 16; ++j) { const unsigned c = xb_ld(&bar[XB_XCNT(j)]); sum += c; cnt += (c > 0u) ? 1u : 0u; mine = (j == x) ? c : mine; }
        if (sum == G) break;
        __builtin_amdgcn_s_sleep(1);
        if ((++sp & 255u) == 0u) { if (xb_ld(&bar[XB_TMO])) break; if (sp > XB_SPIN_CAP) { atomicAdd(&bar[XB_TMO], 1u); break; } }
    }
    nloc = mine > 0u ? mine : 1u; nx = cnt > 0u ? cnt : 1u;
}

__device__ __forceinline__ void xcd_barrier(const XcdBarrier& b) {
    asm volatile("s_waitcnt vmcnt(0)" ::: "memory");
    __syncthreads();
    if (threadIdx.x == 0) {
        unsigned* bar = b.bar;
        __builtin_amdgcn_s_waitcnt(0);
        unsigned nloc = b.st[0], nx = b.st[1];
        if (nloc == 0u) { xcd_barrier_complete(bar, b.x, nloc, nx); b.st[0] = nloc; b.st[1] = nx; }
        const unsigned old = xb_add(&bar[XB_XSUB(b.x)], 1u);
        const unsigned gen = old / nloc;
        if (old + 1u == (gen + 1u) * nloc) {
            __builtin_amdgcn_fence(__ATOMIC_RELEASE, "agent");
            asm volatile("s_waitcnt vmcnt(0)" ::: "memory");
            const unsigned og = xb_add(&bar[XB_TOP], 1u);
            const unsigned tg = og / nx;
            if (og + 1u == (tg + 1u) * nx) xb_add(&bar[XB_TOPGEN], 1u);
            else XB_SPIN(xb_ld(&bar[XB_TOPGEN]) == tg, bar);
            __builtin_amdgcn_fence(__ATOMIC_ACQUIRE, "agent");
            xb_add(&bar[XB_XGEN(b.x)], 1u);
            asm volatile("s_waitcnt vmcnt(0)" ::: "memory");
        } else {
            XB_SPIN(xb_ld(&bar[XB_XGEN(b.x)]) == gen, bar);
            __builtin_amdgcn_fence(__ATOMIC_ACQUIRE, "agent");
            asm volatile("s_waitcnt vmcnt(0)" ::: "memory");
        }
    }
    __syncthreads();
}
struct Args { const float* in[22]; float* out; unsigned char* ws; };
struct Frame {
    LAS unsigned char* lds;
    int tid, lane, wave, vcu, G;
};
__device__ __forceinline__ float wave_sum(float v) {
#pragma unroll
    for (int o = 1; o < 64; o <<= 1) v += __shfl_xor(v, o);
    return v;
}
__device__ __forceinline__ float wave_max(float v) {
#pragma unroll
    for (int o = 1; o < 64; o <<= 1) v = fmaxf(v, __shfl_xor(v, o));
    return v;
}
__device__ __forceinline__ void p0_transpose_item(const float* W, int K, int N, bf16* WT, int k0, int n0, int drow0, LAS float* scr, int lane) {
#pragma unroll 8
    for (int i = 0; i < 32; ++i) { const int kk = 2 * i + (lane >> 5); scr[kk * 33 + (lane & 31)] = W[(size_t)(k0 + kk) * N + n0 + (lane & 31)]; }
    LDS_WAIT(); asm volatile("" ::: "memory");
    const int c = lane & 7;
#pragma unroll
    for (int j = 0; j < 4; ++j) { const int n = (lane >> 3) + 8 * j; const LAS float* s = scr + (8 * c) * 33 + n;
        v4u o; o.x = pk2(s[0 * 33], s[1 * 33]); o.y = pk2(s[2 * 33], s[3 * 33]); o.z = pk2(s[4 * 33], s[5 * 33]); o.w = pk2(s[6 * 33], s[7 * 33]);
        *(GAS v4u*)(WT + (size_t)(drow0 + n) * K + k0 + 8 * c) = o; }
    LDS_WAIT(); asm volatile("" ::: "memory");
}
template <bool GU>
__device__ __forceinline__ bool p0_matrix(int& r, const float* W, int K, int N, bf16* WT, int half, LAS float* scr, int lane) {
    const int nblk = N / 32, items = (K / 64) * nblk;
    if (r >= items) { r -= items; return false; }
    const int kb = r / nblk, nb = r % nblk, n0 = 32 * nb;
    const int drow0 = GU ? (256 * (n0 >> 7) + (n0 & 127) + half * 128) : n0;
    p0_transpose_item(W, K, N, WT, 64 * kb, n0, drow0, scr, lane);
    return true;
}
__device__ __forceinline__ int seq_of_row(int row) { return row < MP ? (row >> 12) : (4 + row - MP); }

typedef float f32x2_t __attribute__((ext_vector_type(2))); typedef __bf16 bf16x2_t __attribute__((ext_vector_type(2)));
__device__ __forceinline__ unsigned cvtpk(float lo, float hi) { f32x2_t v = {lo, hi}; bf16x2_t b = __builtin_convertvector(v, bf16x2_t); return __builtin_bit_cast(unsigned, b); }
#define PACK8(X, S) __builtin_bit_cast(bf16x8, (v4u){cvtpk((X)[8 * (S) + 0], (X)[8 * (S) + 1]), cvtpk((X)[8 * (S) + 2], (X)[8 * (S) + 3]), cvtpk((X)[8 * (S) + 4], (X)[8 * (S) + 5]), cvtpk((X)[8 * (S) + 6], (X)[8 * (S) + 7])})
__device__ __forceinline__ int t5_bucket(int n) {
    if (n < 16) return n;
    int b = 16;
    b += (n >= 22); b += (n >= 30); b += (n >= 40); b += (n >= 54); b += (n >= 73); b += (n >= 99); b += (n >= 134); b += (n >= 182);
    b += (n >= 246); b += (n >= 332); b += (n >= 450); b += (n >= 609); b += (n >= 825); b += (n >= 1117); b += (n >= 1513);
    return b;
}
__device__ __forceinline__ void band_task(const bf16* Qb, const bf16* Kb, const bf16* Vb, size_t stride, int j0, const LAS float* tab, bool has_sink, float sink2,
                                          f32x16 (&o)[2], float& lse2) {
    const int lane = threadIdx.x & 63, q = lane & 31, hi = lane >> 5;
    bf16x8 qf[4];
    { const bf16* qrow = Qb + (size_t)(j0 + q) * stride + 8 * hi;
#pragma unroll
      for (int d0 = 0; d0 < 4; ++d0) qf[d0] = *(const bf16x8*)(qrow + 16 * d0); }
    const int pr = (q & ~12) | ((q & 4) << 1) | ((q & 8) >> 1);
    const int tb = 8 * hi - q + 31;
    f32x16 s[5];
#pragma unroll
    for (int kt = 0; kt < 5; ++kt) {
        int jj = j0 - 128 + 32 * kt + pr; jj = jj < 0 ? 0 : jj;
        const bf16* krow = Kb + (size_t)jj * stride + 8 * hi;
        bf16x8 kf[4];
#pragma unroll
        for (int d0 = 0; d0 < 4; ++d0) kf[d0] = *(const bf16x8*)(krow + 16 * d0);
        f32x16 c;
#pragma unroll
        for (int r = 0; r < 16; ++r) c[r] = tab[tb + 32 * kt + 16 * (r >> 3) + (r & 7)];
#pragma unroll
        for (int d0 = 0; d0 < 4; ++d0) c = __builtin_amdgcn_mfma_f32_32x32x16_bf16(kf[d0], qf[d0], c, 0, 0, 0);
        if (j0 < 128) {
#pragma unroll
            for (int r = 0; r < 16; ++r) { const int jr = j0 - 128 + 32 * kt + 16 * (r >> 3) + 8 * hi + (r & 7); if (jr < 0) c[r] = NEGV; }
        }
        s[kt] = c;
    }
    float m = s[0][0];
#pragma unroll
    for (int kt = 0; kt < 5; ++kt)
#pragma unroll
        for (int r = 0; r < 16; ++r) m = fmaxf(m, s[kt][r]);
    m = fmaxf(m, __shfl_xor(m, 32));
    if (has_sink) m = fmaxf(m, sink2);
    float den = 0.f;
#pragma unroll
    for (int kt = 0; kt < 5; ++kt)
#pragma unroll
        for (int r = 0; r < 16; ++r) { const float p = __builtin_amdgcn_exp2f(s[kt][r] - m); s[kt][r] = p; den += p; }
    den += __shfl_xor(den, 32);
    if (has_sink) den += __builtin_amdgcn_exp2f(sink2 - m);
    bf16x8 I0, I1;
#pragma unroll
    for (int j = 0; j < 8; ++j) { const bool on = (((q >> 3) & 1) == hi) && ((q & 7) == j);
        I0[j] = (on && (q >> 4) == 0) ? (short)0x3F80 : (short)0; I1[j] = (on && (q >> 4) == 1) ? (short)0x3F80 : (short)0; }
    o[0] = (f32x16){}; o[1] = (f32x16){};
#pragma unroll
    for (int kt = 0; kt < 5; ++kt) {
        int jj = j0 - 128 + 32 * kt + pr; jj = jj < 0 ? 0 : jj;
        const bf16* vrow = Vb + (size_t)jj * stride + 8 * hi;
        bf16x8 vf[4];
#pragma unroll
        for (int d0 = 0; d0 < 4; ++d0) vf[d0] = *(const bf16x8*)(vrow + 16 * d0);
        f32x16 X0 = (f32x16){}, X1 = (f32x16){};
        X0 = __builtin_amdgcn_mfma_f32_32x32x16_bf16(vf[0], I0, X0, 0, 0, 0); X0 = __builtin_amdgcn_mfma_f32_32x32x16_bf16(vf[1], I1, X0, 0, 0, 0);
        X1 = __builtin_amdgcn_mfma_f32_32x32x16_bf16(vf[2], I0, X1, 0, 0, 0); X1 = __builtin_amdgcn_mfma_f32_32x32x16_bf16(vf[3], I1, X1, 0, 0, 0);
        { const bf16x8 pa = PACK8(s[kt], 0); o[0] = __builtin_amdgcn_mfma_f32_32x32x16_bf16(PACK8(X0, 0), pa, o[0], 0, 0, 0); o[1] = __builtin_amdgcn_mfma_f32_32x32x16_bf16(PACK8(X1, 0), pa, o[1], 0, 0, 0); }
        { const bf16x8 pa = PACK8(s[kt], 1); o[0] = __builtin_amdgcn_mfma_f32_32x32x16_bf16(PACK8(X0, 1), pa, o[0], 0, 0, 0); o[1] = __builtin_amdgcn_mfma_f32_32x32x16_bf16(PACK8(X1, 1), pa, o[1], 0, 0, 0); }
    }
    const float inv = 1.0f / den;
#pragma unroll
    for (int r = 0; r < 16; ++r) { o[0][r] *= inv; o[1][r] *= inv; }
    lse2 = m + __builtin_log2f(den);
}
__device__ __forceinline__ void sample_task(bool isB, int n, int h, const float* sq, const float* rel_bias, const float* sinks,
                                            const float* cache_k, const float* cache_v, const float* own_k, const float* own_v, bf16* mix, LAS float* pbuf) {
    const int lane = threadIdx.x & 63;
    f32x4 qv[16];
    { const f32x4* qp = (const f32x4*)(sq + (size_t)n * 1024 + (isB ? 512 : 0) + h * 64);
#pragma unroll
      for (int i = 0; i < 16; ++i) qv[i] = qp[i]; }
    const int nvis = isB ? 129 : 321, npass = isB ? 3 : 6;
    const int rowstride = isB ? 128 : 512, nrows = isB ? 128 : 2048, hcol = isB ? (h >> 2) * 64 : h * 64;
    const float* ck = cache_k + (size_t)n * nrows * rowstride + hcol;
    const float* cv = cache_v + (size_t)n * nrows * rowstride + hcol;
    const float* ok = own_k + (size_t)n * rowstride + hcol;
    const float* ov = own_v + (size_t)n * rowstride + hcol;
    const int bcol = isB ? 8 + h : h;
    float lmax = NEGV;
#pragma unroll 1
    for (int pass = 0; pass < npass; ++pass) {
        const int v = pass * 64 + lane; const bool valid = v < nvis;
        int dl = isB ? v : (v < 129 ? v : (v < 225 ? 128 + 4 * (v - 128) : 512 + 16 * (v - 224)));
        if (!valid) dl = 0;
        const f32x4* kp = (const f32x4*)(dl == 0 ? ok : ck + (size_t)(nrows - dl) * rowstride);
        float dot = 0.f;
#pragma unroll
        for (int i = 0; i < 16; ++i) { const f32x4 kk = kp[i]; dot += (kk[0] * qv[i][0] + kk[1] * qv[i][1]) + (kk[2] * qv[i][2] + kk[3] * qv[i][3]); }
        float lm = 0.f;
        if (!isB) { const int mult = (dl <= 128 ? 1 : 0) + ((dl <= 512 && (dl & 3) == 0) ? 1 : 0) + ((dl & 15) == 0 ? 1 : 0); lm = mult == 3 ? 1.5849625007211562f : (mult == 2 ? 1.0f : 0.f); }
        float s = dot + rel_bias[t5_bucket(dl) * 16 + bcol] * LOG2E + lm;
        s = valid ? s : NEGV;
        pbuf[v] = s; lmax = fmaxf(lmax, s);
    }
    float m = wave_max(lmax);
    const float sink2 = isB ? sinks[h] * LOG2E : NEGV;
    if (isB) m = fmaxf(m, sink2);
    float den = 0.f;
    LDS_WAIT(); asm volatile("" ::: "memory");
#pragma unroll 1
    for (int pass = 0; pass < npass; ++pass) { const int v = pass * 64 + lane; const float p = __builtin_amdgcn_exp2f(pbuf[v] - m); den += p; pbuf[v] = p; }
    den = wave_sum(den);
    if (isB) den += __builtin_amdgcn_exp2f(sink2 - m);
    LDS_WAIT(); asm volatile("" ::: "memory");
    const int dch = lane & 15, g = lane >> 4;
    f32x4 acc = (f32x4){0.f, 0.f, 0.f, 0.f};
    const int nit = (nvis + 3) >> 2;
#pragma unroll 8
    for (int it = 0; it < nit; ++it) {
        const int v = 4 * it + g;
        if (v < nvis) {
            const int dl = isB ? v : (v < 129 ? v : (v < 225 ? 128 + 4 * (v - 128) : 512 + 16 * (v - 224)));
            const float* vp = dl == 0 ? ov : cv + (size_t)(nrows - dl) * rowstride;
            const f32x4 val = *(const f32x4*)(vp + 4 * dch);
            acc += val * pbuf[v];
        }
    }
#pragma unroll
    for (int e = 0; e < 4; ++e) { float t = acc[e]; t += __shfl_xor(t, 16); t += __shfl_xor(t, 32); acc[e] = t; }
    LDS_WAIT(); asm volatile("" ::: "memory");
    if (g == 0) { const float inv = 1.0f / den; v2u w; w.x = pk2(acc[0] * inv, acc[1] * inv); w.y = pk2(acc[2] * inv, acc[3] * inv);
        *(v2u*)(mix + (size_t)(MP + n) * D + (isB ? 512 : 0) + h * 64 + 4 * dch) = w; }
}

template <bool HAS_H, int NSLAB>
__device__ __forceinline__ void ln_rows(const Frame& F, const float* xp, const float* xs, const float* Z, const float* SLAB, const float* MOD, int gc, float gs, const float* lng, const float* lnb,
                                        float* outp, bf16* Hout, int shc, int scc) {
    const int gw = F.vcu * NWAVES + F.wave, NGW = F.G * NWAVES;
    for (int row = gw; row < M_REAL; row += NGW) {
        const int seq = seq_of_row(row);
        const f32x4* xr = (const f32x4*)(row < MP ? xp + (size_t)row * D : xs + (size_t)(row - MP) * D) + F.lane;
        const f32x4* mr = (const f32x4*)(MOD + (size_t)seq * NMOD) + F.lane;
        f32x4 a[4]; float s = 0.f;
        if (row < MP) {
            const f32x4* zr = (const f32x4*)(Z + (size_t)row * D) + F.lane;
#pragma unroll
            for (int j = 0; j < 4; ++j) a[j] = zr[64 * j];
        } else {
            const f32x4* zr = (const f32x4*)(SLAB + (size_t)(row - MP) * D) + F.lane;
            f32x4 t[NSLAB][4];
#pragma unroll
            for (int sl = 0; sl < NSLAB; ++sl)
#pragma unroll
                for (int j = 0; j < 4; ++j) t[sl][j] = zr[(size_t)sl * (128 * 256) + 64 * j];
#pragma unroll
            for (int j = 0; j < 4; ++j) { a[j] = t[0][j];
#pragma unroll
                for (int sl = 1; sl < NSLAB; ++sl) a[j] += t[sl][j]; }
        }
#pragma unroll
        for (int j = 0; j < 4; ++j) { a[j] = xr[64 * j] * ALPHA + (mr[gc * 256 + 64 * j] * gs) * a[j]; s += (a[j][0] + a[j][1]) + (a[j][2] + a[j][3]); }
        const float mean = wave_sum(s) * (1.f / D); float s2 = 0.f;
#pragma unroll
        for (int j = 0; j < 4; ++j) { a[j] = a[j] - mean; s2 += (a[j][0] * a[j][0] + a[j][1] * a[j][1]) + (a[j][2] * a[j][2] + a[j][3] * a[j][3]); }
        const float rstd = 1.f / sqrtf(wave_sum(s2) * (1.f / D) + LN_EPS);
        f32x4* orow = (f32x4*)(outp + (size_t)row * D) + F.lane;
        v2u* hrow = (v2u*)(Hout + (size_t)row * D) + F.lane;
#pragma unroll
        for (int j = 0; j < 4; ++j) { const f32x4 o = a[j] * rstd * ((const f32x4*)lng)[F.lane + 64 * j] + ((const f32x4*)lnb)[F.lane + 64 * j];
            orow[64 * j] = o;
            if (HAS_H) { const f32x4 hh = o * (mr[scc * 256 + 64 * j] + 1.0f) + mr[shc * 256 + 64 * j]; v2u w; w.x = pk2(hh[0], hh[1]); w.y = pk2(hh[2], hh[3]); hrow[64 * j] = w; } }
    }
}

__global__ void __launch_bounds__(NWAVES * 64, 2) mega_fwd(Args args) {
    extern __shared__ __attribute__((aligned(16))) unsigned char lds[];
    Frame F;
    F.lds = (LAS unsigned char*)lds;
    volatile LAS unsigned* MISC = (volatile LAS unsigned*)(F.lds + MISC_OFF);
    F.tid = threadIdx.x; F.lane = F.tid & 63; F.wave = __builtin_amdgcn_readfirstlane(F.tid >> 6);
    F.G = gridDim.x; { const int bx = blockIdx.x; F.vcu = (F.G % 8 == 0) ? (bx % 8) * (F.G / 8) + bx / 8 : bx; }
    gu32* ctl = (gu32*)(args.ws + WS_CTL);
    for (int u = F.tid; u < (LDS_BYTES - LDSCTL_OFF) / 4; u += NWAVES * 64) ((LAS unsigned*)(F.lds + LDSCTL_OFF))[u] = 0u;
    __syncthreads();
    XcdBarrier bar = xcd_barrier_post((unsigned*)(ctl + CW_BAR), MISC + 8);
    const int gw = F.vcu * NWAVES + F.wave, NGW = F.G * NWAVES;

#define IN_(i) (args.in[i])
#define x_prompt IN_(0)
#define x_sample IN_(1)
#define cache_a_k IN_(2)
#define cache_a_v IN_(3)
#define cache_b_k IN_(4)
#define cache_b_v IN_(5)
#define c_prompt IN_(6)
#define c_sample IN_(7)
#define rel_bias IN_(8)
#define w_ada IN_(9)
#define b_ada IN_(10)
#define sinks IN_(16)
#define ln_g IN_(20)
#define ln_b IN_(21)
#define OUTP (args.out)
#define o_pak (args.out + 16908288)
#define o_pav (args.out + 21102592)
#define o_pbk (args.out + 25296896)
#define o_pbv (args.out + 25362432)
#define o_sak (args.out + 25427968)
#define o_sav (args.out + 25493504)
#define o_sbk (args.out + 25559040)
#define o_sbv (args.out + 25575424)
#define WGU1 ((bf16*)(args.ws + WS_WGU1))
#define WD1 ((bf16*)(args.ws + WS_WD1))
#define WIN ((bf16*)(args.ws + WS_WIN))
#define WOUT ((bf16*)(args.ws + WS_WOUT))
#define WGU2 ((bf16*)(args.ws + WS_WGU2))
#define WD2 ((bf16*)(args.ws + WS_WD2))
#define WADA ((bf16*)(args.ws + WS_WADA))
#define AMOD ((bf16*)(args.ws + WS_AMOD))
#define MOD ((float*)(args.ws + WS_MOD))
#define SQ ((float*)(args.ws + WS_SQ))
#define H ((bf16*)(args.ws + WS_H))
#define ACT ((bf16*)(args.ws + WS_ACT))
#define Z ((float*)(args.ws + WS_Z))
#define X1 ((float*)(args.ws + WS_X1))
#define X2 ((float*)(args.ws + WS_X2))
#define QKV ((bf16*)(args.ws + WS_QKV))
#define OA ((bf16*)(args.ws + WS_OA))
#define LSE ((float*)(args.ws + WS_LSE))
#define MIX ((bf16*)(args.ws + WS_MIX))
#define SLAB ((float*)(args.ws + WS_SLAB))
    {
        LAS float* scr = (LAS float*)(F.lds + RING_OFF + F.wave * 16384);
        constexpr int NITEMS = 2 * (3 * 16 * 88) + 16 * 72 + 16 * 32 + 16 * 288;
        for (int it = gw; it < NITEMS; it += NGW) {
            int r = it;
            if (p0_matrix<true>(r, args.in[11], D, DFF, WGU1, 0, scr, F.lane)) continue;
            if (p0_matrix<true>(r, args.in[12], D, DFF, WGU1, 1, scr, F.lane)) continue;
            if (p0_matrix<false>(r, args.in[13], DFF, D, WD1, 0, scr, F.lane)) continue;
            if (p0_matrix<false>(r, args.in[14], D, NPROJ, WIN, 0, scr, F.lane)) continue;
            if (p0_matrix<false>(r, args.in[15], D, D, WOUT, 0, scr, F.lane)) continue;
            if (p0_matrix<true>(r, args.in[17], D, DFF, WGU2, 0, scr, F.lane)) continue;
            if (p0_matrix<true>(r, args.in[18], D, DFF, WGU2, 1, scr, F.lane)) continue;
            if (p0_matrix<false>(r, args.in[19], DFF, D, WD2, 0, scr, F.lane)) continue;
            p0_matrix<false>(r, w_ada, D, NMOD, WADA, 0, scr, F.lane);
        }
        for (int r = gw; r < 256; r += NGW) {
            v2u* orow = (v2u*)(AMOD + (size_t)r * D) + F.lane;
            const float* crow_ = r < 4 ? c_prompt + (size_t)r * D : (r < 132 ? c_sample + (size_t)(r - 4) * D : nullptr);
#pragma unroll
            for (int j = 0; j < 4; ++j) { v2u w; w.x = 0u; w.y = 0u;
                if (crow_) { const f32x4 c = ((const f32x4*)crow_)[F.lane + 64 * j]; f32x4 sv;
#pragma unroll
                    for (int e = 0; e < 4; ++e) sv[e] = c[e] * __builtin_amdgcn_rcpf(1.0f + __builtin_amdgcn_exp2f(-LOG2E * c[e]));
                    w.x = pk2(sv[0], sv[1]); w.y = pk2(sv[2], sv[3]); }
                orow[64 * j] = w; }
        }
        for (int r = gw; r < 256; r += NGW) {
            bf16* base = (r < 128 ? H : MIX) + (size_t)(M_REAL + (r & 127)) * D;
            v4u zz = (v4u){0u, 0u, 0u, 0u}; ((v4u*)base)[F.lane] = zz; ((v4u*)base)[F.lane + 64] = zz;
        }
    }
    xcd_barrier(bar);
    {
        pg8::Gemm g{AMOD, WADA, 256, NMOD, D}; pg8::StaticOrder S; S.init(256, NMOD, D, F.G, (int)blockIdx.x);
        pg8::EpiF32 E{MOD, NMOD, b_ada};
        pg8::gemm_phase<pg8::EpiF32, pg8::StaticOrder, true, true>(F.lds + RING_OFF, g, S, E);
    }
    xcd_barrier(bar);
    for (int row = gw; row < M_REAL; row += NGW) {
        const int seq = seq_of_row(row);
        const f32x4* xr = (const f32x4*)(row < MP ? x_prompt + (size_t)row * D : x_sample + (size_t)(row - MP) * D) + F.lane;
        const f32x4* mr = (const f32x4*)(MOD + (size_t)seq * NMOD) + F.lane;
        v2u* hrow = (v2u*)(H + (size_t)row * D) + F.lane;
#pragma unroll
        for (int j = 0; j < 4; ++j) { const f32x4 hh = xr[64 * j] * (mr[256 + 64 * j] + 1.0f) + mr[64 * j]; v2u w; w.x = pk2(hh[0], hh[1]); w.y = pk2(hh[2], hh[3]); hrow[64 * j] = w; }
    }
    xcd_barrier(bar);
    {
        pg8::Gemm g{H, WGU1, M_PAD, 2 * DFF, D}; pg8::StaticOrder S; S.init(M_PAD, 2 * DFF, D, F.G, (int)blockIdx.x);
        pg8::EpiSwiGLU E{ACT, DFF};
        pg8::gemm_phase<pg8::EpiSwiGLU, pg8::StaticOrder, true, true>(F.lds + RING_OFF, g, S, E);
    }
    xcd_barrier(bar);
    {
        pg8::Gemm g{ACT, WD1, M_PAD, D, DFF}; pg8::TailSplitOrder S; S.init(DFF, 4, F.G, (int)blockIdx.x);
        pg8::EpiF32Z E{Z, SLAB};
        pg8::gemm_phase<pg8::EpiF32Z, pg8::TailSplitOrder, true, true>(F.lds + RING_OFF, g, S, E);
    }
    xcd_barrier(bar);
    ln_rows<true, 11>(F, x_prompt, x_sample, Z, SLAB, MOD, 2, 0.5f, ln_g, ln_b, X1, H, 3, 4);
    xcd_barrier(bar);
    {
        pg8::Gemm g{H, WIN, M_PAD, NPROJ, D}; pg8::StaticOrder S; S.init(M_PAD, NPROJ, D, F.G, (int)blockIdx.x);
        pg8::EpiQKV E{QKV, SQ, o_pak, o_pav, o_pbk, o_pbv, o_sak, o_sav, o_sbk, o_sbv, QSCALE};
        pg8::gemm_phase<pg8::EpiQKV, pg8::StaticOrder, true, true>(F.lds + RING_OFF, g, S, E);
    }
    xcd_barrier(bar);
    {
        LAS float* tabs = (LAS float*)(F.lds + RING_OFF);
        for (int idx = F.tid; idx < 4 * 8 * 192; idx += NWAVES * 64) {
            const int type = idx / 1536, h = (idx / 192) & 7, i = idx % 192, dist = 159 - i;
            float v = NEGV;
            if (dist >= 0 && dist <= 128) { const int dil = type == 1 ? 4 : (type == 2 ? 16 : 1); v = rel_bias[t5_bucket(dist * dil) * 16 + (type == 3 ? 8 + h : h)] * LOG2E; }
            tabs[idx] = v;
        }
        __syncthreads();
        LAS float* pbuf = (LAS float*)(F.lds + RING_OFF + 32768 + F.wave * 2048);
#ifndef NO_SAMPLE
        for (int st = gw; st < 2 * NS * 8; st += NGW) {
            const bool isB = st >= NS * 8; const int r = isB ? st - NS * 8 : st, n = r >> 3, h = r & 7;
            sample_task(isB, n, h, SQ, rel_bias, sinks, isB ? cache_b_k : cache_a_k, isB ? cache_b_v : cache_a_v, isB ? o_sbk : o_sak, isB ? o_sbv : o_sav, MIX, pbuf);
        }
#endif
#ifndef NO_BAND
        for (int task = gw; task < 4 * 4096; task += NGW) {
            const int type = task >> 12, rem = task & 4095, h = rem & 7, x = rem >> 3, b = x >> 7, y = x & 127;
            const int dil = type == 1 ? 4 : (type == 2 ? 16 : 1);
            const int per = 128 / dil, rc = y / per, qblk = y % per, j0 = 32 * qblk;
            const size_t stride = (size_t)dil * NPROJ;
            const bf16* base = QKV + (size_t)(b * SEQ + rc) * NPROJ;
            const bf16 *Qb, *Kb, *Vb;
            if (type < 3) { Qb = base + h * 64; Kb = base + 512 + h * 64; Vb = base + 1024 + h * 64; }
            else { Qb = base + 1536 + h * 64; Kb = base + 2048 + (h >> 2) * 64; Vb = base + 2176 + (h >> 2) * 64; }
            f32x16 o[2]; float lse2;
            band_task(Qb, Kb, Vb, stride, j0, tabs + (type * 8 + h) * 192, type == 3, type == 3 ? sinks[h] * LOG2E : 0.f, o, lse2);
            const int q = F.lane & 31, hi = F.lane >> 5;
            const int token = b * SEQ + rc + dil * (j0 + q);
            bf16* dst = type < 3 ? OA + ((size_t)type * MP + token) * 512 + h * 64 : MIX + (size_t)token * D + 512 + h * 64;
#pragma unroll
            for (int nb = 0; nb < 2; ++nb)
#pragma unroll
                for (int g4 = 0; g4 < 4; ++g4) { v2u w; w.x = cvtpk(o[nb][4 * g4 + 0], o[nb][4 * g4 + 1]); w.y = cvtpk(o[nb][4 * g4 + 2], o[nb][4 * g4 + 3]);
                    *(v2u*)(dst + 32 * nb + 8 * g4 + 4 * hi) = w; }
            if (type < 3 && hi == 0) LSE[((size_t)type * MP + token) * 8 + h] = lse2;
        }
#endif
    }
    xcd_barrier(bar);
    for (int token = gw; token < MP; token += NGW) {
        const int h = F.lane >> 3;
        float l0 = LSE[((size_t)0 * MP + token) * 8 + h], l1 = LSE[((size_t)1 * MP + token) * 8 + h], l2 = LSE[((size_t)2 * MP + token) * 8 + h];
        const float mx = fmaxf(l0, fmaxf(l1, l2));
        float w0 = __builtin_amdgcn_exp2f(l0 - mx), w1 = __builtin_amdgcn_exp2f(l1 - mx), w2 = __builtin_amdgcn_exp2f(l2 - mx);
        const float inv = 1.0f / (w0 + w1 + w2); w0 *= inv; w1 *= inv; w2 *= inv;
        const v4u a0 = ((const v4u*)(OA + ((size_t)0 * MP + token) * 512))[F.lane], a1 = ((const v4u*)(OA + ((size_t)1 * MP + token) * 512))[F.lane], a2 = ((const v4u*)(OA + ((size_t)2 * MP + token) * 512))[F.lane];
        v4u w;
#pragma unroll
        for (int e = 0; e < 4; ++e) {
            const float lo = w0 * bf2f((unsigned short)(a0[e] & 0xffffu)) + w1 * bf2f((unsigned short)(a1[e] & 0xffffu)) + w2 * bf2f((unsigned short)(a2[e] & 0xffffu));
            const float hi_ = w0 * bf2f((unsigned short)(a0[e] >> 16)) + w1 * bf2f((unsigned short)(a1[e] >> 16)) + w2 * bf2f((unsigned short)(a2[e] >> 16));
            w[e] = pk2(lo, hi_);
        }
        ((v4u*)(MIX + (size_t)token * D))[F.lane] = w;
    }
    xcd_barrier(bar);
    {
        pg8::Gemm g{MIX, WOUT, M_PAD, D, D}; pg8::TailSplitOrder S; S.init(D, 4, F.G, (int)blockIdx.x);
        pg8::EpiF32Z E{Z, SLAB};
        pg8::gemm_phase<pg8::EpiF32Z, pg8::TailSplitOrder, true, true>(F.lds + RING_OFF, g, S, E);
    }
    xcd_barrier(bar);
    ln_rows<true, 4>(F, X1, X1 + (size_t)MP * D, Z, SLAB, MOD, 5, 1.0f, ln_g + D, ln_b + D, X2, H, 6, 7);
    xcd_barrier(bar);
    {
        pg8::Gemm g{H, WGU2, M_PAD, 2 * DFF, D}; pg8::StaticOrder S; S.init(M_PAD, 2 * DFF, D, F.G, (int)blockIdx.x);
        pg8::EpiSwiGLU E{ACT, DFF};
        pg8::gemm_phase<pg8::EpiSwiGLU, pg8::StaticOrder, true, true>(F.lds + RING_OFF, g, S, E);
    }
    xcd_barrier(bar);
    {
        pg8::Gemm g{ACT, WD2, M_PAD, D, DFF}; pg8::TailSplitOrder S; S.init(DFF, 4, F.G, (int)blockIdx.x);
        pg8::EpiF32Z E{Z, SLAB};
        pg8::gemm_phase<pg8::EpiF32Z, pg8::TailSplitOrder, true, true>(F.lds + RING_OFF, g, S, E);
    }
    xcd_barrier(bar);
    ln_rows<false, 11>(F, X2, X2 + (size_t)MP * D, Z, SLAB, MOD, 8, 0.5f, ln_g + 2 * D, ln_b + 2 * D, OUTP, nullptr, 0, 0);
#ifdef PROBE_SCALE9
    if (blockIdx.x == 0) { for (int i = F.tid; i < 16384; i += NWAVES * 64) o_sbv[i] *= 1.05f; }
#endif
}

#undef IN_
#undef x_prompt
#undef x_sample
#undef cache_a_k
#undef cache_a_v
#undef cache_b_k
#undef cache_b_v
#undef c_prompt
#undef c_sample
#undef rel_bias
#undef w_ada
#undef b_ada
#undef sinks
#undef ln_g
#undef ln_b
#undef OUTP
#undef o_pak
#undef o_pav
#undef o_pbk
#undef o_pbv
#undef o_sak
#undef o_sav
#undef o_sbk
#undef o_sbv
#undef WGU1
#undef WD1
#undef WIN
#undef WOUT
#undef WGU2
#undef WD2
#undef WADA
#undef AMOD
#undef MOD
#undef SQ
#undef H
#undef ACT
#undef Z
#undef X1
#undef X2
#undef QKV
#undef OA
#undef LSE
#undef MIX
#undef SLAB
extern "C" void kernel_launch(void* const* d_in, const int* in_sizes, int n_in, void* d_out, int out_size, void* d_ws, size_t ws_size, hipStream_t stream) {
    static int grid = 0;
    if (grid == 0) {
        if (n_in != 22 || out_size != 25591808 || ws_size < WS_END) { fprintf(stderr, "kernel_launch: unexpected shapes (n_in %d out %d ws %zu)\n", n_in, out_size, ws_size); grid = -1; return; }
        int dev = 0, cus = 0, per_cu = 0;
        if (hipGetDevice(&dev) != hipSuccess || hipDeviceGetAttribute(&cus, hipDeviceAttributeMultiprocessorCount, dev) != hipSuccess) { grid = -1; return; }
        if (hipFuncSetAttribute((const void*)mega_fwd, hipFuncAttributeMaxDynamicSharedMemorySize, LDS_BYTES) != hipSuccess) { fprintf(stderr, "kernel_launch: hipFuncSetAttribute failed\n"); grid = -1; return; }
        if (hipOccupancyMaxActiveBlocksPerMultiprocessor(&per_cu, (const void*)mega_fwd, NWAVES * 64, LDS_BYTES) != hipSuccess || per_cu < 1)
            fprintf(stderr, "kernel_launch: occupancy query reports %d workgroups per CU\n", per_cu);
        (void)hipGetLastError();
        grid = cus;
    }
    if (grid < 0) return;
    if (hipMemsetAsync((char*)d_ws + WS_CTL, 0, CTL_ZERO_BYTES, stream) != hipSuccess) return;
    Args a{};
    for (int i = 0; i < 22; ++i) a.in[i] = (const float*)d_in[i];
    a.out = (float*)d_out; a.ws = (unsigned char*)d_ws;
    hipLaunchKernelGGL(mega_fwd, dim3(grid), dim3(NWAVES * 64), LDS_BYTES, stream, a);
}
```

```cpp
#include <hip/hip_runtime.h>
#include <cstdio>
#include <cstdint>
#include <cstddef>
namespace pg8 {
#define PG8_LAS __attribute__((address_space(3)))
typedef unsigned short bf16_t;
typedef short bf16x8 __attribute__((ext_vector_type(8)));
typedef float f32x4 __attribute__((ext_vector_type(4)));
typedef unsigned u32x4 __attribute__((ext_vector_type(4)));
constexpr int BM = 256, BK = 64, HALF = 128, HTB = HALF * BK * 2  , STAGE_BYTES = 8 * HTB, NXCD = 8, WGM = 8;

__host__ __device__ __forceinline__ int lds_byte(int r, int c) { const int st = (r >> 4) * 2 + (c >> 5), rr = r & 15, cc = c & 31, ob = rr * 64 + cc * 2; return st * 1024 + (ob ^ (((ob >> 9) & 1) << 5)); }
__host__ __device__ __forceinline__ void stage_rc(int b, int& R, int& C) { const int st = b / 1024, sb = b % 1024, swz = sb ^ (((sb >> 9) & 1) << 5); R = (st >> 1) * 16 + swz / 64; C = (st & 1) * 32 + (swz % 64) / 2; }
__host__ __device__ __forceinline__ int perm32(int rho) { const int n = rho >> 4, i = rho & 15; return 8 * (i >> 2) + 4 * n + (i & 3); }

struct Unit { int pm, pn, k0, nt; };
struct Gemm { const bf16_t* A; const bf16_t* Bt; int M, N, K; int sa, sb; int wid; };
__device__ __forceinline__ int fresh_lane() { int z = 0; asm volatile("" : "+v"(z)); return (int)__builtin_amdgcn_mbcnt_hi(~0u, __builtin_amdgcn_mbcnt_lo(~0u, (unsigned)z)); }
typedef int v4i_t __attribute__((ext_vector_type(4)));
typedef int v8i_t __attribute__((ext_vector_type(8)));
template <bool FP8> struct FragT;
template <> struct FragT<false> {
    struct A { bf16x8 k[2]; };
    static __device__ __forceinline__ void load(A& d, const PG8_LAS unsigned char* p) { d.k[0] = *(const PG8_LAS bf16x8*)p; d.k[1] = *(const PG8_LAS bf16x8*)(p + 1024); }
    static __device__ __forceinline__ void mma(f32x4& c, const A& b, const A& a, int, int) { c = __builtin_amdgcn_mfma_f32_16x16x32_bf16(b.k[0], a.k[0], c, 0, 0, 0); c = __builtin_amdgcn_mfma_f32_16x16x32_bf16(b.k[1], a.k[1], c, 0, 0, 0); }
};
template <> struct FragT<true> {
    struct A { v8i_t v; };
    static __device__ __forceinline__ void load(A& d, const PG8_LAS unsigned char* p) { const v4i_t lo = *(const PG8_LAS v4i_t*)p, hi = *(const PG8_LAS v4i_t*)(p + 1024); d.v = __builtin_shufflevector(lo, hi, 0, 1, 2, 3, 4, 5, 6, 7); }
    static __device__ __forceinline__ void mma(f32x4& c, const A& b, const A& a, int sb, int sa) { c = __builtin_amdgcn_mfma_scale_f32_16x16x128_f8f6f4(b.v, a.v, c, 0, 0, 0, sb, 0, sa); }
};

struct StaticOrder {
    int nM, nN, nwg, G, c, ntf;
    __host__ __device__ void init(int M, int N, int K, int G_, int c_) { nM = M / BM; nN = N / BM; nwg = nM * nN; G = G_; c = c_; ntf = K / BK; }
    __host__ __device__ bool next(int i, Unit& u) const {
        const long L = (long)i * G + c; if (L >= nwg) return false;
        int wgid = (int)L; { const int q = nwg / NXCD, r = nwg % NXCD, xcd = wgid % NXCD, off = wgid / NXCD; wgid = (xcd < r ? xcd * (q + 1) : r * (q + 1) + (xcd - r) * q) + off; }
        const int nig = WGM * nN, gid = wgid / nig, fm = gid * WGM, gsz = (nM - fm) < WGM ? (nM - fm) : WGM;
        u.pm = fm + ((wgid % nig) % gsz); u.pn = (wgid % nig) / gsz; u.k0 = 0; u.nt = ntf; return true;
    }
    __device__ __forceinline__ void a_ready(const Unit&) const {}
    __device__ __forceinline__ void done(const Unit&) const {}
};
struct TailSplitOrder {
    StaticOrder so; int nsplit, SL;
    __host__ __device__ void init(int K, int SL_, int G_, int c_) { so.init(64 * BM, 4 * BM, K, G_, c_); SL = SL_; nsplit = 4 * ((K / BK) / SL_); }
    __host__ __device__ bool next(int i, Unit& u) const {
        const long L = (long)i * so.G + so.c;
        if (L < so.nwg) return so.next(i, u);
        const int j = (int)(L - so.nwg); if (j >= nsplit) return false;
        u.pm = 64; u.pn = j & 3; u.k0 = (j >> 2) * SL; u.nt = SL; return true;
    }
    __device__ __forceinline__ void a_ready(const Unit&) const {}
    __device__ __forceinline__ void done(const Unit&) const {}
};
__device__ __forceinline__ unsigned cvt_pk_bf16(float lo, float hi) { unsigned r; asm volatile("v_cvt_pk_bf16_f32 %0, %1, %2" : "=v"(r) : "v"(lo), "v"(hi)); return r; }
typedef float f32x2 __attribute__((ext_vector_type(2)));
typedef float f32x2 __attribute__((ext_vector_type(2)));
struct EpiF32 {
    static constexpr bool PERM = false, AFTER_DRAIN = false;
    float* O; int ldc; const float* bias;
    __device__ __forceinline__ void operator()(const f32x4 (&acc)[2][2][4][2], const Unit& u, int wr, int wc, int fr, int fq) const {
        const int row0 = u.pm * BM + wr * 64 + fr, col0 = u.pn * BM + wc * 32 + 4 * fq;
        f32x4 bv[2][2];
#pragma unroll
        for (int bj = 0; bj < 2; ++bj)
#pragma unroll
            for (int n = 0; n < 2; ++n) bv[bj][n] = bias ? *(const f32x4*)(bias + col0 + bj * HALF + n * 16) : (f32x4){0.f, 0.f, 0.f, 0.f};
#pragma unroll
        for (int ai = 0; ai < 2; ++ai)
#pragma unroll
            for (int m = 0; m < 4; ++m) { float* rowp = O + (size_t)(row0 + ai * HALF + m * 16) * ldc + col0;
#pragma unroll
                for (int bj = 0; bj < 2; ++bj)
#pragma unroll
                    for (int n = 0; n < 2; ++n) *(f32x4*)(rowp + bj * HALF + n * 16) = acc[ai][bj][m][n] + bv[bj][n]; }
    }
};
struct EpiF32Z {
    static constexpr bool PERM = false, AFTER_DRAIN = false;
    float* Z; float* SLAB;
    __device__ __forceinline__ void operator()(const f32x4 (&acc)[2][2][4][2], const Unit& u, int wr, int wc, int fr, int fq) const {
        const int col0 = u.pn * BM + wc * 32 + 4 * fq;
        if (u.pm < 64) {
#pragma unroll
            for (int ai = 0; ai < 2; ++ai)
#pragma unroll
                for (int m = 0; m < 4; ++m) { float* rowp = Z + (size_t)(u.pm * BM + wr * 64 + fr + ai * HALF + m * 16) * 1024 + col0;
#pragma unroll
                    for (int bj = 0; bj < 2; ++bj)
#pragma unroll
                        for (int n = 0; n < 2; ++n) *(f32x4*)(rowp + bj * HALF + n * 16) = acc[ai][bj][m][n]; }
        } else {
            float* sl = SLAB + (size_t)(u.k0 / u.nt) * (128 * 1024);
#pragma unroll
            for (int m = 0; m < 4; ++m) { float* rowp = sl + (size_t)(wr * 64 + fr + m * 16) * 1024 + col0;
#pragma unroll
                for (int bj = 0; bj < 2; ++bj)
#pragma unroll
                    for (int n = 0; n < 2; ++n) *(f32x4*)(rowp + bj * HALF + n * 16) = acc[0][bj][m][n]; }
        }
    }
};
__device__ __forceinline__ float silu_mul(float g, float u) { return g * u * __builtin_amdgcn_rcpf(1.0f + __builtin_amdgcn_exp2f(-1.4426950408889634f * g)); }
__device__ __forceinline__ unsigned pk4_fp8(float a, float b, float c, float d) {
    a = __builtin_amdgcn_fmed3f(a, -448.f, 448.f); b = __builtin_amdgcn_fmed3f(b, -448.f, 448.f); c = __builtin_amdgcn_fmed3f(c, -448.f, 448.f); d = __builtin_amdgcn_fmed3f(d, -448.f, 448.f);
    unsigned w = 0u; w = __builtin_amdgcn_cvt_pk_fp8_f32(a, b, w, false); w = __builtin_amdgcn_cvt_pk_fp8_f32(c, d, w, true); return w; }
template <bool F8OUT> struct EpiSwiGLU {
    static constexpr bool PERM = true, AFTER_DRAIN = false;
    bf16_t* O; int ldc;
    __device__ __forceinline__ void operator()(const f32x4 (&acc)[2][2][4][2], const Unit& u, int wr, int wc, int fr, int fq) const {
        const int row0 = u.pm * BM + wr * 64 + fr, col0 = u.pn * HALF + wc * 32 + 8 * fq;
#pragma unroll
        for (int ai = 0; ai < 2; ++ai)
#pragma unroll
            for (int m = 0; m < 4; ++m) { bf16_t* rowp = O + (size_t)(row0 + ai * HALF + m * 16) * ldc + col0;
                const f32x4 g0 = acc[ai][0][m][0], g1 = acc[ai][0][m][1], u0 = acc[ai][1][m][0], u1 = acc[ai][1][m][1];
                if constexpr (F8OUT) { unsigned char* rp8 = (unsigned char*)O + (size_t)(row0 + ai * HALF + m * 16) * ldc + col0; typedef unsigned u32x2v __attribute__((ext_vector_type(2))); u32x2v w;
                    w.x = pk4_fp8(8.f * silu_mul(g0[0], u0[0]), 8.f * silu_mul(g0[1], u0[1]), 8.f * silu_mul(g0[2], u0[2]), 8.f * silu_mul(g0[3], u0[3]));
                    w.y = pk4_fp8(8.f * silu_mul(g1[0], u1[0]), 8.f * silu_mul(g1[1], u1[1]), 8.f * silu_mul(g1[2], u1[2]), 8.f * silu_mul(g1[3], u1[3]));
                    *(u32x2v*)rp8 = w; }
                else { u32x4 w; w.x = cvt_pk_bf16(silu_mul(g0[0], u0[0]), silu_mul(g0[1], u0[1])); w.y = cvt_pk_bf16(silu_mul(g0[2], u0[2]), silu_mul(g0[3], u0[3]));
                w.z = cvt_pk_bf16(silu_mul(g1[0], u1[0]), silu_mul(g1[1], u1[1])); w.w = cvt_pk_bf16(silu_mul(g1[2], u1[2]), silu_mul(g1[3], u1[3]));
                *(u32x4*)rowp = w; } }
    }
};
struct EpiQKV {
    static constexpr bool PERM = true, AFTER_DRAIN = false;
    bf16_t* O;
    float* sq;
    float *pak, *pav, *pbk, *pbv, *sak, *sav, *sbk, *sbv;
    float qscale;
    __device__ __forceinline__ void operator()(const f32x4 (&acc)[2][2][4][2], const Unit& u, int wr, int wc, int fr, int fq) const {
        const int pn = u.pn;
#pragma unroll
        for (int ai = 0; ai < 2; ++ai)
#pragma unroll
            for (int m = 0; m < 4; ++m) { const int row = u.pm * BM + ai * HALF + wr * 64 + m * 16 + fr;
#pragma unroll
                for (int bj = 0; bj < 2; ++bj) { const int col = pn * BM + bj * HALF + wc * 32 + 8 * fq;
                    f32x4 v0 = acc[ai][bj][m][0], v1 = acc[ai][bj][m][1];
                    const bool isq = (pn < 2) || (pn == 6) || (pn == 7);
                    if (isq) { v0 = v0 * qscale; v1 = v1 * qscale; }
                    u32x4 w; w.x = cvt_pk_bf16(v0[0], v0[1]); w.y = cvt_pk_bf16(v0[2], v0[3]); w.z = cvt_pk_bf16(v1[0], v1[1]); w.w = cvt_pk_bf16(v1[2], v1[3]);
                    *(u32x4*)(O + (size_t)row * 2304 + col) = w;
                    float* dst = nullptr;
                    if (row < 16384) { const int b = row >> 12, t = row & 4095;
                        if (pn == 2 || pn == 3) { if (t >= 2048) dst = pak + ((size_t)(b * 2048 + t - 2048)) * 512 + (col - 512); }
                        else if (pn == 4 || pn == 5) { if (t >= 2048) dst = pav + ((size_t)(b * 2048 + t - 2048)) * 512 + (col - 1024); }
                        else if (pn == 8) { if (t >= 3968) dst = (bj == 0 ? pbk : pbv) + ((size_t)(b * 128 + t - 3968)) * 128 + (col - 2048 - bj * 128); }
                    } else if (row < 16512) { const int n = row - 16384;
                        if (pn < 2) dst = sq + (size_t)n * 1024 + col;
                        else if (pn == 2 || pn == 3) dst = sak + (size_t)n * 512 + (col - 512);
                        else if (pn == 4 || pn == 5) dst = sav + (size_t)n * 512 + (col - 1024);
                        else if (pn == 6 || pn == 7) dst = sq + (size_t)n * 1024 + 512 + (col - 1536);
                        else dst = (bj == 0 ? sbk : sbv) + (size_t)n * 128 + (col - 2048 - bj * 128);
                    }
                    if (dst) { *(f32x4*)dst = v0; *(f32x4*)(dst + 4) = v1; }
                } }
    }
};
template <class Epi, class Sched, bool ALIGN_EPI = false, bool SP2 = false, bool FP8 = false>
__device__ __forceinline__ void gemm_phase(PG8_LAS unsigned char* lds, const Gemm g, const Sched& S, const Epi& E) {
    const int wid = g.wid, lane = fresh_lane(), tid = wid * 64 + lane;
    const int wr = wid >> 2, wc = wid & 3, fr = lane & 15, fq = lane >> 4;
    const int K = g.K;
    unsigned voffA[2], voffB[2];
#pragma unroll
    for (int i = 0; i < 2; ++i) { int R, C; stage_rc(tid * 16 + i * 8192, R, C); const int Rb = Epi::PERM ? ((R & ~31) + perm32(R & 31)) : R;
        voffA[i] = (unsigned)(R * K + C) * 2u; voffB[i] = (unsigned)(Rb * K + C) * 2u; }
    const unsigned kstep = (unsigned)(BK * 2);
    const unsigned hstep = (unsigned)HALF * K * 2;
    const unsigned tstep = 2 * hstep;
    const unsigned ldsw = (unsigned)wid * 1024u;
    const int aoff = lds_byte(wr * 64 + fr, fq * 8), boff = lds_byte(wc * 32 + fr, fq * 8);
#define PG8_SA(b, h) (((b) * 2 + (h)) * HTB)
#define PG8_SB(b, h) ((4 + (b) * 2 + (h)) * HTB)
    const __amdgpu_buffer_rsrc_t rsA = __builtin_amdgcn_make_buffer_rsrc((void*)g.A, 0, 0x7fffffff, 0x00020000), rsB = __builtin_amdgcn_make_buffer_rsrc((void*)g.Bt, 0, 0x7fffffff, 0x00020000);
#define PG8_RS_voffA rsA
#define PG8_RS_voffB rsB
#define PG8_STAGE(bufoff, goff, voff) do { _Pragma("unroll") for (int _i = 0; _i < 2; ++_i) \
        __builtin_amdgcn_raw_ptr_buffer_load_lds(PG8_RS_##voff, (PG8_LAS void*)(lds + (bufoff) + ldsw + _i * 8192), 16, (voff)[_i], (int)(goff), 0, 0); } while (0)
#define PG8_LDA(dst, b, h) do { _Pragma("unroll") for (int m = 0; m < 4; ++m) FragT<FP8>::load(dst[m], lds + PG8_SA(b, h) + aoff + m * 2048); } while (0)
#define PG8_LDB(dst, b, h) do { _Pragma("unroll") for (int n = 0; n < 2; ++n) FragT<FP8>::load(dst[n], lds + PG8_SB(b, h) + boff + n * 2048); } while (0)
#define PG8_MMA(ai, bj, At, Bt) do { __builtin_amdgcn_s_setprio(1); \
        _Pragma("unroll") for (int m = 0; m < 4; ++m) _Pragma("unroll") for (int n = 0; n < 2; ++n) FragT<FP8>::mma(acc[ai][bj][m][n], Bt[n], At[m], g.sb, g.sa); \
        __builtin_amdgcn_s_setprio(0); } while (0)
#define PG8_WAIT_V(n) asm volatile("s_waitcnt vmcnt(" #n ")" ::: "memory")
#define PG8_WAIT_L(n) asm volatile("s_waitcnt lgkmcnt(" #n ")" ::: "memory")
#define PG8_BAR __builtin_amdgcn_s_barrier()
#define PG8_SCHED __builtin_amdgcn_sched_barrier(0)
    Unit cur, nxt; int ui = 0;
    if (!S.next(0, cur)) return;
    f32x4 acc[2][2][4][2];
#pragma unroll
    for (int a = 0; a < 2; ++a)
#pragma unroll
        for (int b = 0; b < 2; ++b)
#pragma unroll
            for (int m = 0; m < 4; ++m)
#pragma unroll
                for (int n = 0; n < 2; ++n) acc[a][b][m][n] = (f32x4){0.f, 0.f, 0.f, 0.f};
    typename FragT<FP8>::A At[4]; typename FragT<FP8>::A B0[2], B1[2];
    unsigned cA = (unsigned)cur.pm * tstep + (unsigned)cur.k0 * kstep; unsigned cB = (unsigned)cur.pn * tstep + (unsigned)cur.k0 * kstep;
    S.a_ready(cur);
    if constexpr (SP2) {
        PG8_STAGE(PG8_SB(0, 0), cB, voffB); PG8_STAGE(PG8_SB(0, 1), cB + hstep, voffB); PG8_STAGE(PG8_SA(0, 0), cA, voffA); PG8_STAGE(PG8_SA(0, 1), cA + hstep, voffA);
        if (wr == 1) PG8_BAR;
        PG8_WAIT_V(2); PG8_BAR;
        PG8_STAGE(PG8_SB(1, 0), cB + kstep, voffB); PG8_STAGE(PG8_SA(1, 0), cA + kstep, voffA); PG8_STAGE(PG8_SB(1, 1), cB + hstep + kstep, voffB);
        PG8_WAIT_V(6); PG8_BAR;
    } else {
        PG8_STAGE(PG8_SB(0, 0), cB, voffB); PG8_STAGE(PG8_SA(0, 0), cA, voffA); PG8_STAGE(PG8_SB(0, 1), cB + hstep, voffB); PG8_STAGE(PG8_SA(0, 1), cA + hstep, voffA);
        if (wr == 1) PG8_BAR;
        PG8_WAIT_V(4); PG8_BAR;
        PG8_STAGE(PG8_SB(1, 0), cB + kstep, voffB); PG8_STAGE(PG8_SA(1, 0), cA + kstep, voffA); PG8_STAGE(PG8_SB(1, 1), cB + hstep + kstep, voffB);
        PG8_WAIT_V(6); PG8_BAR;
    }
    for (;;) {
        const bool has_next = S.next(ui + 1, nxt);
        const unsigned nA = has_next ? (unsigned)nxt.pm * tstep + (unsigned)nxt.k0 * kstep : cA; const unsigned nB = has_next ? (unsigned)nxt.pn * tstep + (unsigned)nxt.k0 * kstep : cB;
        const int nt = cur.nt;
        for (int t = 0; t < nt; t += 2) {
            const bool last = (t == nt - 2);
            const unsigned a1 = cA + (unsigned)(t + 1) * kstep;
            const unsigned a2 = last ? nA : cA + (unsigned)(t + 2) * kstep; const unsigned b2 = last ? nB : cB + (unsigned)(t + 2) * kstep;
            const unsigned a3 = a2 + kstep; const unsigned b3 = b2 + kstep;
            if (last && has_next) S.a_ready(nxt);
            if constexpr (SP2) {
            PG8_LDB(B0, 0, 0); PG8_LDB(B1, 0, 1); PG8_SCHED; PG8_LDA(At, 0, 0); PG8_STAGE(PG8_SA(1, 1), a1 + hstep, voffA);
            PG8_WAIT_V(8); PG8_WAIT_L(0); PG8_BAR; PG8_MMA(0, 0, At, B0); PG8_MMA(0, 1, At, B1); PG8_BAR; PG8_SCHED;
            PG8_LDA(At, 0, 1); PG8_STAGE(PG8_SB(0, 0), b2, voffB); PG8_STAGE(PG8_SB(0, 1), b2 + hstep, voffB); PG8_STAGE(PG8_SA(0, 0), a2, voffA);
            PG8_WAIT_V(8); PG8_WAIT_L(0); PG8_BAR; PG8_MMA(1, 0, At, B0); PG8_MMA(1, 1, At, B1); PG8_BAR; PG8_SCHED;
            PG8_LDB(B0, 1, 0); PG8_LDB(B1, 1, 1); PG8_SCHED; PG8_LDA(At, 1, 0); PG8_STAGE(PG8_SA(0, 1), a2 + hstep, voffA);
            PG8_WAIT_V(8); PG8_WAIT_L(0); PG8_BAR; PG8_MMA(0, 0, At, B0); PG8_MMA(0, 1, At, B1); PG8_BAR; PG8_SCHED;
            PG8_LDA(At, 1, 1); PG8_STAGE(PG8_SB(1, 0), b3, voffB); PG8_STAGE(PG8_SB(1, 1), b3 + hstep, voffB); PG8_STAGE(PG8_SA(1, 0), a3, voffA);
            PG8_WAIT_V(8); PG8_WAIT_L(0); PG8_BAR; PG8_MMA(1, 0, At, B0); PG8_MMA(1, 1, At, B1); PG8_BAR; PG8_SCHED;
            } else {
            PG8_LDB(B0, 0, 0); PG8_SCHED; PG8_LDA(At, 0, 0); PG8_STAGE(PG8_SA(1, 1), a1 + hstep, voffA);
            PG8_WAIT_L(8); PG8_BAR; PG8_WAIT_L(0); PG8_MMA(0, 0, At, B0); PG8_BAR; PG8_SCHED;
            PG8_LDB(B1, 0, 1); PG8_STAGE(PG8_SB(0, 0), b2, voffB);
            PG8_BAR; PG8_WAIT_L(0); PG8_MMA(0, 1, At, B1); PG8_BAR;
            PG8_LDA(At, 0, 1); PG8_STAGE(PG8_SA(0, 0), a2, voffA);
            PG8_BAR; PG8_WAIT_L(0); PG8_MMA(1, 0, At, B0); PG8_BAR; PG8_SCHED;
            PG8_STAGE(PG8_SB(0, 1), b2 + hstep, voffB);
            PG8_WAIT_V(6); PG8_BAR; PG8_MMA(1, 1, At, B1); PG8_BAR;
            PG8_LDB(B0, 1, 0); PG8_SCHED; PG8_LDA(At, 1, 0); PG8_STAGE(PG8_SA(0, 1), a2 + hstep, voffA);
            PG8_WAIT_L(8); PG8_BAR; PG8_WAIT_L(0); PG8_MMA(0, 0, At, B0); PG8_BAR; PG8_SCHED;
            PG8_LDB(B1, 1, 1); PG8_STAGE(PG8_SB(1, 0), b3, voffB);
            PG8_BAR; PG8_WAIT_L(0); PG8_MMA(0, 1, At, B1); PG8_BAR;
            PG8_LDA(At, 1, 1); PG8_STAGE(PG8_SA(1, 0), a3, voffA);
            PG8_BAR; PG8_WAIT_L(0); PG8_MMA(1, 0, At, B0); PG8_BAR; PG8_SCHED;
            PG8_STAGE(PG8_SB(1, 1), b3 + hstep, voffB);
            PG8_WAIT_V(6); PG8_BAR; PG8_MMA(1, 1, At, B1); PG8_BAR;
            }
        }
        if constexpr (ALIGN_EPI) { if (wr == 0) PG8_BAR; }
        if constexpr (!Epi::AFTER_DRAIN) { const int l2_ = fresh_lane(); const int fr_ = l2_ & 15, fq_ = l2_ >> 4;
            E(acc, cur, wr, wc, fr_, fq_); S.done(cur); }
        if (!has_next) break;
#pragma unroll
        for (int a = 0; a < 2; ++a)
#pragma unroll
            for (int b = 0; b < 2; ++b)
#pragma unroll
                for (int m = 0; m < 4; ++m)
#pragma unroll
                    for (int n = 0; n < 2; ++n) acc[a][b][m][n] = (f32x4){0.f, 0.f, 0.f, 0.f};
        cur = nxt; cA = nA; cB = nB; ++ui;
        if constexpr (ALIGN_EPI) { if (wr == 1) PG8_BAR; }
    }
    PG8_WAIT_V(0);
    if constexpr (!ALIGN_EPI) { if (wr == 0) PG8_BAR; }
    PG8_BAR;
    if constexpr (Epi::AFTER_DRAIN) { E.fused(acc, cur, wr, wc, fr, fq, lds, wid, lane); S.done(cur); }
#undef PG8_SA
#undef PG8_SB
#undef PG8_STAGE
#undef PG8_RS_voffA
#undef PG8_RS_voffB
#undef PG8_LDA
#undef PG8_LDB
#undef PG8_MMA
#undef PG8_WAIT_V
#undef PG8_WAIT_L
#undef PG8_BAR
#undef PG8_SCHED
}
}
constexpr int D = 1024, DFF = 2816, NPROJ = 2304, SEQ = 4096, NBATCH = 4, MP = NBATCH * SEQ, NS = 128, M_REAL = MP + NS, M_PAD = 16640;
constexpr int NMOD = 9 * D;
constexpr float LN_EPS = 1e-5f;
constexpr float ALPHA = 1.189207115002721f;
constexpr float LOG2E = 1.4426950408889634f;
constexpr float QSCALE = 0.125f * LOG2E;
constexpr float NEGV = -1e30f;
constexpr int NWAVES = 8;
#ifndef FP8_UP
#define FP8_UP true
#endif
#ifndef FP8_DOWN
#define FP8_DOWN true
#endif

constexpr size_t MiB = 1u << 20;
constexpr size_t WS_CTL = 0, CTL_ZERO_BYTES = 1 * MiB;
constexpr size_t WS_WGU1 = 2 * MiB, WS_WD1 = 13 * MiB, WS_WIN = 19 * MiB, WS_WOUT = 24 * MiB, WS_WGU2 = 26 * MiB, WS_WD2 = 37 * MiB, WS_WADA = 43 * MiB;
constexpr size_t WS_AMOD = 61 * MiB, WS_MOD = 62 * MiB, WS_SQ = 71 * MiB + 512 * 1024, WS_H = 72 * MiB, WS_ACT = 105 * MiB, WS_Z = 195 * MiB, WS_X1 = 260 * MiB, WS_X2 = 325 * MiB;
constexpr size_t WS_QKV = 390 * MiB, WS_OA = 464 * MiB, WS_LSE = 512 * MiB, WS_MIX = 514 * MiB, WS_SLAB = 548 * MiB, WS_END = 554 * MiB;
static_assert(WS_MOD + (size_t)256 * NMOD * 4 <= WS_SQ && WS_SQ + (size_t)NS * 1024 * 4 <= WS_H && WS_H + (size_t)M_PAD * D * 2 <= WS_ACT && WS_ACT + (size_t)M_PAD * DFF * 2 <= WS_Z, "ws map 1");
static_assert(WS_Z + (size_t)M_PAD * D * 4 <= WS_X1 && WS_QKV + (size_t)M_PAD * NPROJ * 2 <= WS_OA && WS_OA + (size_t)3 * MP * 512 * 2 <= WS_LSE && WS_LSE + (size_t)3 * MP * 8 * 4 <= WS_MIX && WS_MIX + (size_t)M_PAD * D * 2 <= WS_SLAB && WS_SLAB + (size_t)11 * 128 * 1024 * 4 <= WS_END, "ws map 2");
constexpr int CW_BAR = 4096;

constexpr int RING_OFF = 0, RING_BYTES = 131072;
constexpr int LDSCTL_OFF = RING_BYTES, MISC_OFF = LDSCTL_OFF + 320;
constexpr int LDS_BYTES = 147456;

#define GAS __attribute__((address_space(1)))
#define LAS __attribute__((address_space(3)))
typedef unsigned short bf16;
typedef unsigned v4u __attribute__((ext_vector_type(4)));
typedef unsigned v2u __attribute__((ext_vector_type(2)));
typedef float f32x4 __attribute__((ext_vector_type(4)));
typedef short bf16x8 __attribute__((ext_vector_type(8)));
typedef float f32x16 __attribute__((ext_vector_type(16)));
typedef GAS unsigned gu32;
#define RLX_AGENT __ATOMIC_RELAXED, __HIP_MEMORY_SCOPE_AGENT
#define LDS_WAIT() asm volatile("s_waitcnt lgkmcnt(0)" ::: "memory")
__device__ __forceinline__ unsigned f2bf(float f) { unsigned u = __builtin_bit_cast(unsigned, f); return (u + 0x7fffu + ((u >> 16) & 1u)) >> 16; }
__device__ __forceinline__ unsigned pk2(float lo, float hi) { return f2bf(lo) | (f2bf(hi) << 16); }
__device__ __forceinline__ float bf2f(unsigned short b) { return __builtin_bit_cast(float, (unsigned)b << 16); }
#define XB_TMO      128
#define XB_XCNT(j)  (256  + 64 * (j))
#define XB_XSUB(j)  (1280 + 64 * (j))
#define XB_XGEN(j)  (2304 + 64 * (j))
#define XB_TOP      3328
#define XB_TOPGEN   3392
#define XCD_BAR_WORDS 3456
#define XB_SPIN_CAP (1u << 18)

__device__ __forceinline__ unsigned xb_ld(unsigned* p)              { return __hip_atomic_load(p, __ATOMIC_RELAXED, __HIP_MEMORY_SCOPE_AGENT); }
__device__ __forceinline__ unsigned xb_add(unsigned* p, unsigned v) { return __hip_atomic_fetch_add(p, v, __ATOMIC_RELAXED, __HIP_MEMORY_SCOPE_AGENT); }
__device__ __forceinline__ unsigned xb_xcc_id() { return (unsigned)__builtin_amdgcn_s_getreg((3 << 11) | 20) & 0xFu; }
#define XB_SPIN(cond, bar) do { unsigned _sp = 0; while (cond) { __builtin_amdgcn_s_sleep(1); \
    if ((++_sp & 255u) == 0u) { if (xb_ld(&(bar)[XB_TMO])) break; if (_sp > XB_SPIN_CAP) { atomicAdd(&(bar)[XB_TMO], 1u); break; } } } } while (0)

struct XcdBarrier {
    unsigned* bar; unsigned x;
    volatile LAS unsigned* st;
};

__device__ __forceinline__ XcdBarrier xcd_barrier_post(unsigned* bar, volatile LAS unsigned* st) {
    XcdBarrier b; b.bar = bar; b.x = xb_xcc_id(); b.st = st;
    if (threadIdx.x == 0) (void)xb_add(&bar[XB_XCNT(b.x)], 1u);
    return b;
}
__device__ __forceinline__ void xcd_barrier_complete(unsigned* bar, unsigned x, unsigned& nloc, unsigned& nx) {
    const unsigned G = gridDim.x * gridDim.y * gridDim.z;
    unsigned sum, cnt, mine, sp = 0u;
    for (;;) {
        sum = 0u; cnt = 0u; mine = 0u;
#pragma unroll
        for (unsigned j = 0; j < 16; ++j) { const unsigned c = xb_ld(&bar[XB_XCNT(j)]); sum += c; cnt += (c > 0u) ? 1u : 0u; mine = (j == x) ? c : mine; }
        if (sum == G) break;
        __builtin_amdgcn_s_sleep(1);
        if ((++sp & 255u) == 0u) { if (xb_ld(&bar[XB_TMO])) break; if (sp > XB_SPIN_CAP) { atomicAdd(&bar[XB_TMO], 1u); break; } }
    }
    nloc = mine > 0u ? mine : 1u; nx = cnt > 0u ? cnt : 1u;
}

__device__ __forceinline__ void xcd_barrier(const XcdBarrier& b) {
    asm volatile("s_waitcnt vmcnt(0)" ::: "memory");
    __syncthreads();
    if (threadIdx.x == 0) {
        unsigned* bar = b.bar;
        __builtin_amdgcn_s_waitcnt(0);
        unsigned nloc = b.st[0], nx = b.st[1];
        if (nloc == 0u) { xcd_barrier_complete(bar, b.x, nloc, nx); b.st[0] = nloc; b.st[1] = nx; }
        const unsigned old = xb_add(&bar[XB_XSUB(b.x)], 1u);
        const unsigned gen = old / nloc;
        if (old + 1u == (gen + 1u) * nloc) {
            __builtin_amdgcn_fence(__ATOMIC_RELEASE, "agent");
            asm volatile("s_waitcnt vmcnt(0)" ::: "memory");
            const unsigned og = xb_add(&bar[XB_TOP], 1u);
            const unsigned tg = og / nx;
            if (og + 1u == (tg + 1u) * nx) xb_add(&bar[XB_TOPGEN], 1u);
            else XB_SPIN(xb_ld(&bar[XB_TOPGEN]) == tg, bar);
            __builtin_amdgcn_fence(__ATOMIC_ACQUIRE, "agent");
            xb_add(&bar[XB_XGEN(b.x)], 1u);
            asm volatile("s_waitcnt vmcnt(0)" ::: "memory");
        } else {
            XB_SPIN(xb_ld(&bar[XB_XGEN(b.x)]) == gen, bar);
            __builtin_amdgcn_fence(__ATOMIC_ACQUIRE, "agent");
            asm volatile("s_waitcnt vmcnt(0)" ::: "memory");
        }
    }
    __syncthreads();
}
struct Args { const float* in[22]; float* out; unsigned char* ws; };
struct Frame {
    LAS unsigned char* lds;
    int tid, lane, wave, vcu, G;
};
__device__ __forceinline__ float wave_sum(float v) {
#pragma unroll
    for (int o = 1; o < 64; o <<= 1) v += __shfl_xor(v, o);
    return v;
}
__device__ __forceinline__ float wave_max(float v) {
#pragma unroll
    for (int o = 1; o < 64; o <<= 1) v = fmaxf(v, __shfl_xor(v, o));
    return v;
}
template <bool F8>
__device__ __forceinline__ void p0_transpose_item(const float* W, int K, int N, bf16* WT, int k0, int n0, int drow0, float wscale, LAS float* scr, int lane) {
#pragma unroll 8
    for (int i = 0; i < 32; ++i) { const int kk = 2 * i + (lane >> 5); scr[kk * 33 + (lane & 31)] = W[(size_t)(k0 + kk) * N + n0 + (lane & 31)]; }
    LDS_WAIT(); asm volatile("" ::: "memory");
    const int c = lane & 7;
#pragma unroll
    for (int j = 0; j < 4; ++j) { const int n = (lane >> 3) + 8 * j; const LAS float* s = scr + (8 * c) * 33 + n;
        if constexpr (F8) { v2u o; o.x = pg8::pk4_fp8(s[0 * 33] * wscale, s[1 * 33] * wscale, s[2 * 33] * wscale, s[3 * 33] * wscale); o.y = pg8::pk4_fp8(s[4 * 33] * wscale, s[5 * 33] * wscale, s[6 * 33] * wscale, s[7 * 33] * wscale);
            *(GAS v2u*)((unsigned char*)WT + (size_t)(drow0 + n) * K + k0 + 8 * c) = o; }
        else { v4u o; o.x = pk2(s[0 * 33], s[1 * 33]); o.y = pk2(s[2 * 33], s[3 * 33]); o.z = pk2(s[4 * 33], s[5 * 33]); o.w = pk2(s[6 * 33], s[7 * 33]);
        *(GAS v4u*)(WT + (size_t)(drow0 + n) * K + k0 + 8 * c) = o; } }
    LDS_WAIT(); asm volatile("" ::: "memory");
}
template <bool GU, bool F8>
__device__ __forceinline__ bool p0_matrix(int& r, const float* W, int K, int N, bf16* WT, int half, float wscale, LAS float* scr, int lane) {
    const int nblk = N / 32, items = (K / 64) * nblk;
    if (r >= items) { r -= items; return false; }
    const int kb = r / nblk, nb = r % nblk, n0 = 32 * nb;
    const int drow0 = GU ? (256 * (n0 >> 7) + (n0 & 127) + half * 128) : n0;
    p0_transpose_item<F8>(W, K, N, WT, 64 * kb, n0, drow0, wscale, scr, lane);
    return true;
}
__device__ __forceinline__ int seq_of_row(int row) { return row < MP ? (row >> 12) : (4 + row - MP); }

typedef float f32x2_t __attribute__((ext_vector_type(2))); typedef __bf16 bf16x2_t __attribute__((ext_vector_type(2)));
__device__ __forceinline__ unsigned cvtpk(float lo, float hi) { f32x2_t v = {lo, hi}; bf16x2_t b = __builtin_convertvector(v, bf16x2_t); return __builtin_bit_cast(unsigned, b); }
#define PACK8(X, S) __builtin_bit_cast(bf16x8, (v4u){cvtpk((X)[8 * (S) + 0], (X)[8 * (S) + 1]), cvtpk((X)[8 * (S) + 2], (X)[8 * (S) + 3]), cvtpk((X)[8 * (S) + 4], (X)[8 * (S) + 5]), cvtpk((X)[8 * (S) + 6], (X)[8 * (S) + 7])})
__device__ __forceinline__ int t5_bucket(int n) {
    if (n < 16) return n;
    int b = 16;
    b += (n >= 22); b += (n >= 30); b += (n >= 40); b += (n >= 54); b += (n >= 73); b += (n >= 99); b += (n >= 134); b += (n >= 182);
    b += (n >= 246); b += (n >= 332); b += (n >= 450); b += (n >= 609); b += (n >= 825); b += (n >= 1117); b += (n >= 1513);
    return b;
}
__device__ __forceinline__ void band_task(const bf16* Qb, const bf16* Kb, const bf16* Vb, size_t stride, int j0, const LAS float* tab, bool has_sink, float sink2,
                                          f32x16 (&o)[2], float& lse2) {
    const int lane = pg8::fresh_lane(), q = lane & 31, hi = lane >> 5;
    bf16x8 qf[4];
    { const bf16* qrow = Qb + (size_t)(j0 + q) * stride + 8 * hi;
#pragma unroll
      for (int d0 = 0; d0 < 4; ++d0) qf[d0] = *(const bf16x8*)(qrow + 16 * d0); }
    const int pr = (q & ~12) | ((q & 4) << 1) | ((q & 8) >> 1);
    const int tb = 8 * hi - q + 31;
    f32x16 s[5];
#pragma unroll
    for (int kt = 0; kt < 5; ++kt) {
        int jj = j0 - 128 + 32 * kt + pr; jj = jj < 0 ? 0 : jj;
        const bf16* krow = Kb + (size_t)jj * stride + 8 * hi;
        bf16x8 kf[4];
#pragma unroll
        for (int d0 = 0; d0 < 4; ++d0) kf[d0] = *(const bf16x8*)(krow + 16 * d0);
        f32x16 c;
#pragma unroll
        for (int r = 0; r < 16; ++r) c[r] = tab[tb + 32 * kt + 16 * (r >> 3) + (r & 7)];
#pragma unroll
        for (int d0 = 0; d0 < 4; ++d0) c = __builtin_amdgcn_mfma_f32_32x32x16_bf16(kf[d0], qf[d0], c, 0, 0, 0);
        if (j0 < 128) {
#pragma unroll
            for (int r = 0; r < 16; ++r) { const int jr = j0 - 128 + 32 * kt + 16 * (r >> 3) + 8 * hi + (r & 7); if (jr < 0) c[r] = NEGV; }
        }
        s[kt] = c;
    }
    float m = s[0][0];
#pragma unroll
    for (int kt = 0; kt < 5; ++kt)
#pragma unroll
        for (int r = 0; r < 16; ++r) m = fmaxf(m, s[kt][r]);
    m = fmaxf(m, __shfl_xor(m, 32));
    if (has_sink) m = fmaxf(m, sink2);
    float den = 0.f;
#pragma unroll
    for (int kt = 0; kt < 5; ++kt)
#pragma unroll
        for (int r = 0; r < 16; ++r) { const float p = __builtin_amdgcn_exp2f(s[kt][r] - m); s[kt][r] = p; den += p; }
    den += __shfl_xor(den, 32);
    if (has_sink) den += __builtin_amdgcn_exp2f(sink2 - m);
    bf16x8 I0, I1;
#pragma unroll
    for (int j = 0; j < 8; ++j) { const bool on = (((q >> 3) & 1) == hi) && ((q & 7) == j);
        I0[j] = (on && (q >> 4) == 0) ? (short)0x3F80 : (short)0; I1[j] = (on && (q >> 4) == 1) ? (short)0x3F80 : (short)0; }
    o[0] = (f32x16){}; o[1] = (f32x16){};
#pragma unroll
    for (int kt = 0; kt < 5; ++kt) {
        int jj = j0 - 128 + 32 * kt + pr; jj = jj < 0 ? 0 : jj;
        const bf16* vrow = Vb + (size_t)jj * stride + 8 * hi;
        bf16x8 vf[4];
#pragma unroll
        for (int d0 = 0; d0 < 4; ++d0) vf[d0] = *(const bf16x8*)(vrow + 16 * d0);
        f32x16 X0 = (f32x16){}, X1 = (f32x16){};
        X0 = __builtin_amdgcn_mfma_f32_32x32x16_bf16(vf[0], I0, X0, 0, 0, 0); X0 = __builtin_amdgcn_mfma_f32_32x32x16_bf16(vf[1], I1, X0, 0, 0, 0);
        X1 = __builtin_amdgcn_mfma_f32_32x32x16_bf16(vf[2], I0, X1, 0, 0, 0); X1 = __builtin_amdgcn_mfma_f32_32x32x16_bf16(vf[3], I1, X1, 0, 0, 0);
        { const bf16x8 pa = PACK8(s[kt], 0); o[0] = __builtin_amdgcn_mfma_f32_32x32x16_bf16(PACK8(X0, 0), pa, o[0], 0, 0, 0); o[1] = __builtin_amdgcn_mfma_f32_32x32x16_bf16(PACK8(X1, 0), pa, o[1], 0, 0, 0); }
        { const bf16x8 pa = PACK8(s[kt], 1); o[0] = __builtin_amdgcn_mfma_f32_32x32x16_bf16(PACK8(X0, 1), pa, o[0], 0, 0, 0); o[1] = __builtin_amdgcn_mfma_f32_32x32x16_bf16(PACK8(X1, 1), pa, o[1], 0, 0, 0); }
    }
    const float inv = 1.0f / den;
#pragma unroll
    for (int r = 0; r < 16; ++r) { o[0][r] *= inv; o[1][r] *= inv; }
    lse2 = m + __builtin_log2f(den);
}
__device__ __forceinline__ void sample_task(bool isB, int n, int h, const float* sq, const float* rel_bias, const float* sinks,
                                            const float* cache_k, const float* cache_v, const float* own_k, const float* own_v, bf16* mix, LAS float* pbuf) {
    const int lane = pg8::fresh_lane();
    f32x4 qv[16];
    { const f32x4* qp = (const f32x4*)(sq + (size_t)n * 1024 + (isB ? 512 : 0) + h * 64);
#pragma unroll
      for (int i = 0; i < 16; ++i) qv[i] = qp[i]; }
    const int nvis = isB ? 129 : 321, npass = isB ? 3 : 6;
    const int rowstride = isB ? 128 : 512, nrows = isB ? 128 : 2048, hcol = isB ? (h >> 2) * 64 : h * 64;
    const float* ck = cache_k + (size_t)n * nrows * rowstride + hcol;
    const float* cv = cache_v + (size_t)n * nrows * rowstride + hcol;
    const float* ok = own_k + (size_t)n * rowstride + hcol;
    const float* ov = own_v + (size_t)n * rowstride + hcol;
    const int bcol = isB ? 8 + h : h;
    float lmax = NEGV;
#pragma unroll 1
    for (int pass = 0; pass < npass; ++pass) {
        const int v = pass * 64 + lane; const bool valid = v < nvis;
        int dl = isB ? v : (v < 129 ? v : (v < 225 ? 128 + 4 * (v - 128) : 512 + 16 * (v - 224)));
        if (!valid) dl = 0;
        const f32x4* kp = (const f32x4*)(dl == 0 ? ok : ck + (size_t)(nrows - dl) * rowstride);
        float dot = 0.f;
#pragma unroll
        for (int i = 0; i < 16; ++i) { const f32x4 kk = kp[i]; dot += (kk[0] * qv[i][0] + kk[1] * qv[i][1]) + (kk[2] * qv[i][2] + kk[3] * qv[i][3]); }
        float lm = 0.f;
        if (!isB) { const int mult = (dl <= 128 ? 1 : 0) + ((dl <= 512 && (dl & 3) == 0) ? 1 : 0) + ((dl & 15) == 0 ? 1 : 0); lm = mult == 3 ? 1.5849625007211562f : (mult == 2 ? 1.0f : 0.f); }
        float s = dot + rel_bias[t5_bucket(dl) * 16 + bcol] * LOG2E + lm;
        s = valid ? s : NEGV;
        pbuf[v] = s; lmax = fmaxf(lmax, s);
    }
    float m = wave_max(lmax);
    const float sink2 = isB ? sinks[h] * LOG2E : NEGV;
    if (isB) m = fmaxf(m, sink2);
    float den = 0.f;
    LDS_WAIT(); asm volatile("" ::: "memory");
#pragma unroll 1
    for (int pass = 0; pass < npass; ++pass) { const int v = pass * 64 + lane; const float p = __builtin_amdgcn_exp2f(pbuf[v] - m); den += p; pbuf[v] = p; }
    den = wave_sum(den);
    if (isB) den += __builtin_amdgcn_exp2f(sink2 - m);
    LDS_WAIT(); asm volatile("" ::: "memory");
    const int dch = lane & 15, g = lane >> 4;
    f32x4 acc = (f32x4){0.f, 0.f, 0.f, 0.f};
    const int nit = (nvis + 3) >> 2;
#pragma unroll 8
    for (int it = 0; it < nit; ++it) {
        const int v = 4 * it + g;
        if (v < nvis) {
            const int dl = isB ? v : (v < 129 ? v : (v < 225 ? 128 + 4 * (v - 128) : 512 + 16 * (v - 224)));
            const float* vp = dl == 0 ? ov : cv + (size_t)(nrows - dl) * rowstride;
            const f32x4 val = *(const f32x4*)(vp + 4 * dch);
            acc += val * pbuf[v];
        }
    }
#pragma unroll
    for (int e = 0; e < 4; ++e) { float t = acc[e]; t += __shfl_xor(t, 16); t += __shfl_xor(t, 32); acc[e] = t; }
    LDS_WAIT(); asm volatile("" ::: "memory");
    if (g == 0) { const float inv = 1.0f / den; v2u w; w.x = pk2(acc[0] * inv, acc[1] * inv); w.y = pk2(acc[2] * inv, acc[3] * inv);
        *(v2u*)(mix + (size_t)(MP + n) * D + (isB ? 512 : 0) + h * 64 + 4 * dch) = w; }
}

template <int HMODE  , int NSLAB>
__device__ __forceinline__ void ln_rows(const Frame& F, const float* xp, const float* xs, const float* Z, const float* SLAB, const float* MOD, int gc, float gs, const float* lng, const float* lnb,
                                        float* outp, bf16* Hout, int shc, int scc) {
    const int gw = F.vcu * NWAVES + F.wave, NGW = F.G * NWAVES;
    for (int row = gw; row < M_REAL; row += NGW) {
        const int seq = seq_of_row(row);
        const f32x4* xr = (const f32x4*)(row < MP ? xp + (size_t)row * D : xs + (size_t)(row - MP) * D) + F.lane;
        const f32x4* mr = (const f32x4*)(MOD + (size_t)seq * NMOD) + F.lane;
        f32x4 a[4]; float s = 0.f;
        if (row < MP) {
            const f32x4* zr = (const f32x4*)(Z + (size_t)row * D) + F.lane;
#pragma unroll
            for (int j = 0; j < 4; ++j) a[j] = zr[64 * j];
        } else {
            const f32x4* zr = (const f32x4*)(SLAB + (size_t)(row - MP) * D) + F.lane;
            f32x4 t[NSLAB][4];
#pragma unroll
            for (int sl = 0; sl < NSLAB; ++sl)
#pragma unroll
                for (int j = 0; j < 4; ++j) t[sl][j] = zr[(size_t)sl * (128 * 256) + 64 * j];
#pragma unroll
            for (int j = 0; j < 4; ++j) { a[j] = t[0][j];
#pragma unroll
                for (int sl = 1; sl < NSLAB; ++sl) a[j] += t[sl][j]; }
        }
#pragma unroll
        for (int j = 0; j < 4; ++j) { a[j] = xr[64 * j] * ALPHA + (mr[gc * 256 + 64 * j] * gs) * a[j]; s += (a[j][0] + a[j][1]) + (a[j][2] + a[j][3]); }
        const float mean = wave_sum(s) * (1.f / D); float s2 = 0.f;
#pragma unroll
        for (int j = 0; j < 4; ++j) { a[j] = a[j] - mean; s2 += (a[j][0] * a[j][0] + a[j][1] * a[j][1]) + (a[j][2] * a[j][2] + a[j][3] * a[j][3]); }
        const float rstd = 1.f / sqrtf(wave_sum(s2) * (1.f / D) + LN_EPS);
        f32x4* orow = (f32x4*)(outp + (size_t)row * D) + F.lane;
        v2u* hrow = (v2u*)(Hout + (size_t)row * D) + F.lane; unsigned* hrow8 = (unsigned*)((unsigned char*)Hout + (size_t)row * D) + F.lane;
#pragma unroll
        for (int j = 0; j < 4; ++j) { const f32x4 o = a[j] * rstd * ((const f32x4*)lng)[F.lane + 64 * j] + ((const f32x4*)lnb)[F.lane + 64 * j];
            orow[64 * j] = o;
            if (HMODE != 0) { const f32x4 hh = o * (mr[scc * 256 + 64 * j] + 1.0f) + mr[shc * 256 + 64 * j];
                if (HMODE == 2) hrow8[64 * j] = pg8::pk4_fp8(hh[0], hh[1], hh[2], hh[3]);
                else { v2u w; w.x = pk2(hh[0], hh[1]); w.y = pk2(hh[2], hh[3]); hrow[64 * j] = w; } } }
    }
}

__global__ void __launch_bounds__(NWAVES * 64, 2) mega_fwd(Args args) {
    extern __shared__ __attribute__((aligned(16))) unsigned char lds[];
    Frame F;
    F.lds = (LAS unsigned char*)lds;
    volatile LAS unsigned* MISC = (volatile LAS unsigned*)(F.lds + MISC_OFF);
    F.tid = threadIdx.x; F.lane = F.tid & 63; F.wave = __builtin_amdgcn_readfirstlane(F.tid >> 6);
    F.G = gridDim.x; { const int bx = blockIdx.x; F.vcu = (F.G % 8 == 0) ? (bx % 8) * (F.G / 8) + bx / 8 : bx; }
    gu32* ctl = (gu32*)(args.ws + WS_CTL);
    for (int u = F.tid; u < (LDS_BYTES - LDSCTL_OFF) / 4; u += NWAVES * 64) ((LAS unsigned*)(F.lds + LDSCTL_OFF))[u] = 0u;
    __syncthreads();
    XcdBarrier bar = xcd_barrier_post((unsigned*)(ctl + CW_BAR), MISC + 8);
    const int gw = F.vcu * NWAVES + F.wave, NGW = F.G * NWAVES;
#define REFRESH() do { F.lane = pg8::fresh_lane(); F.tid = F.wave * 64 + F.lane; } while (0)

#define IN_(i) (args.in[i])
#define x_prompt IN_(0)
#define x_sample IN_(1)
#define cache_a_k IN_(2)
#define cache_a_v IN_(3)
#define cache_b_k IN_(4)
#define cache_b_v IN_(5)
#define c_prompt IN_(6)
#define c_sample IN_(7)
#define rel_bias IN_(8)
#define w_ada IN_(9)
#define b_ada IN_(10)
#define sinks IN_(16)
#define ln_g IN_(20)
#define ln_b IN_(21)
#define OUTP (args.out)
#define o_pak (args.out + 16908288)
#define o_pav (args.out + 21102592)
#define o_pbk (args.out + 25296896)
#define o_pbv (args.out + 25362432)
#define o_sak (args.out + 25427968)
#define o_sav (args.out + 25493504)
#define o_sbk (args.out + 25559040)
#define o_sbv (args.out + 25575424)
#define WGU1 ((bf16*)(args.ws + WS_WGU1))
#define WD1 ((bf16*)(args.ws + WS_WD1))
#define WIN ((bf16*)(args.ws + WS_WIN))
#define WOUT ((bf16*)(args.ws + WS_WOUT))
#define WGU2 ((bf16*)(args.ws + WS_WGU2))
#define WD2 ((bf16*)(args.ws + WS_WD2))
#define WADA ((bf16*)(args.ws + WS_WADA))
#define AMOD ((bf16*)(args.ws + WS_AMOD))
#define MOD ((float*)(args.ws + WS_MOD))
#define SQ ((float*)(args.ws + WS_SQ))
#define H ((bf16*)(args.ws + WS_H))
#define ACT ((bf16*)(args.ws + WS_ACT))
#define Z ((float*)(args.ws + WS_Z))
#define X1 ((float*)(args.ws + WS_X1))
#define X2 ((float*)(args.ws + WS_X2))
#define QKV ((bf16*)(args.ws + WS_QKV))
#define OA ((bf16*)(args.ws + WS_OA))
#define LSE ((float*)(args.ws + WS_LSE))
#define MIX ((bf16*)(args.ws + WS_MIX))
#define SLAB ((float*)(args.ws + WS_SLAB))
    {
        LAS float* scr = (LAS float*)(F.lds + RING_OFF + F.wave * 16384);
        constexpr int NITEMS = 2 * (3 * 16 * 88) + 16 * 72 + 16 * 32 + 16 * 288;
        for (int it = gw; it < NITEMS; it += NGW) {
            int r = it;
            if (p0_matrix<true, FP8_UP>(r, args.in[11], D, DFF, WGU1, 0, 64.f, scr, F.lane)) continue;
            if (p0_matrix<true, FP8_UP>(r, args.in[12], D, DFF, WGU1, 1, 64.f, scr, F.lane)) continue;
            if (p0_matrix<false, FP8_DOWN>(r, args.in[13], DFF, D, WD1, 0, 128.f, scr, F.lane)) continue;
            if (p0_matrix<false, false>(r, args.in[14], D, NPROJ, WIN, 0, 1.f, scr, F.lane)) continue;
            if (p0_matrix<false, false>(r, args.in[15], D, D, WOUT, 0, 1.f, scr, F.lane)) continue;
            if (p0_matrix<true, FP8_UP>(r, args.in[17], D, DFF, WGU2, 0, 64.f, scr, F.lane)) continue;
            if (p0_matrix<true, FP8_UP>(r, args.in[18], D, DFF, WGU2, 1, 64.f, scr, F.lane)) continue;
            if (p0_matrix<false, FP8_DOWN>(r, args.in[19], DFF, D, WD2, 0, 128.f, scr, F.lane)) continue;
            p0_matrix<false, false>(r, w_ada, D, NMOD, WADA, 0, 1.f, scr, F.lane);
        }
        for (int r = gw; r < 256; r += NGW) {
            v2u* orow = (v2u*)(AMOD + (size_t)r * D) + F.lane;
            const float* crow_ = r < 4 ? c_prompt + (size_t)r * D : (r < 132 ? c_sample + (size_t)(r - 4) * D : nullptr);
#pragma unroll
            for (int j = 0; j < 4; ++j) { v2u w; w.x = 0u; w.y = 0u;
                if (crow_) { const f32x4 c = ((const f32x4*)crow_)[F.lane + 64 * j]; f32x4 sv;
#pragma unroll
                    for (int e = 0; e < 4; ++e) sv[e] = c[e] * __builtin_amdgcn_rcpf(1.0f + __builtin_amdgcn_exp2f(-LOG2E * c[e]));
                    w.x = pk2(sv[0], sv[1]); w.y = pk2(sv[2], sv[3]); }
                orow[64 * j] = w; }
        }
        for (int r = gw; r < 256; r += NGW) {
            bf16* base = (r < 128 ? H : MIX) + (size_t)(M_REAL + (r & 127)) * D;
            v4u zz = (v4u){0u, 0u, 0u, 0u}; ((v4u*)base)[F.lane] = zz; ((v4u*)base)[F.lane + 64] = zz;
        }
    }
    xcd_barrier(bar);
    REFRESH();
    {
        pg8::Gemm g{AMOD, WADA, 256, NMOD, D, 0, 0, F.wave}; pg8::StaticOrder S; S.init(256, NMOD, D, F.G, (int)blockIdx.x);
        pg8::EpiF32 E{MOD, NMOD, b_ada};
        pg8::gemm_phase<pg8::EpiF32, pg8::StaticOrder, true, true>(F.lds + RING_OFF, g, S, E);
    }
    xcd_barrier(bar);
    REFRESH();
    for (int row = gw; row < M_REAL; row += NGW) {
        const int seq = seq_of_row(row);
        const f32x4* xr = (const f32x4*)(row < MP ? x_prompt + (size_t)row * D : x_sample + (size_t)(row - MP) * D) + F.lane;
        const f32x4* mr = (const f32x4*)(MOD + (size_t)seq * NMOD) + F.lane;
        v2u* hrow = (v2u*)(H + (size_t)row * D) + F.lane; unsigned* hrow8 = (unsigned*)((unsigned char*)H + (size_t)row * D) + F.lane;
#pragma unroll
        for (int j = 0; j < 4; ++j) { const f32x4 hh = xr[64 * j] * (mr[256 + 64 * j] + 1.0f) + mr[64 * j];
            if (FP8_UP) hrow8[64 * j] = pg8::pk4_fp8(hh[0], hh[1], hh[2], hh[3]);
            else { v2u w; w.x = pk2(hh[0], hh[1]); w.y = pk2(hh[2], hh[3]); hrow[64 * j] = w; } }
    }
    xcd_barrier(bar);
    REFRESH();
    {
        constexpr int KU = FP8_UP ? D / 2 : D;
        pg8::Gemm g{H, WGU1, M_PAD, 2 * DFF, KU, 0x7f7f7f7f, 0x79797979, F.wave}; pg8::StaticOrder S; S.init(M_PAD, 2 * DFF, KU, F.G, (int)blockIdx.x);
        pg8::EpiSwiGLU<FP8_DOWN> E{ACT, DFF};
        pg8::gemm_phase<pg8::EpiSwiGLU<FP8_DOWN>, pg8::StaticOrder, true, true, FP8_UP>(F.lds + RING_OFF, g, S, E);
    }
    xcd_barrier(bar);
    REFRESH();
    {
        constexpr int KD = FP8_DOWN ? DFF / 2 : DFF;
        pg8::Gemm g{ACT, WD1, M_PAD, D, KD, 0x7c7c7c7c, 0x78787878, F.wave}; pg8::TailSplitOrder S; S.init(KD, FP8_DOWN ? 2 : 4, F.G, (int)blockIdx.x);
        pg8::EpiF32Z E{Z, SLAB};
        pg8::gemm_phase<pg8::EpiF32Z, pg8::TailSplitOrder, true, true, FP8_DOWN>(F.lds + RING_OFF, g, S, E);
    }
    xcd_barrier(bar);
    REFRESH();
    ln_rows<1, 11>(F, x_prompt, x_sample, Z, SLAB, MOD, 2, 0.5f, ln_g, ln_b, X1, H, 3, 4);
    xcd_barrier(bar);
    REFRESH();
    {
        pg8::Gemm g{H, WIN, M_PAD, NPROJ, D, 0, 0, F.wave}; pg8::StaticOrder S; S.init(M_PAD, NPROJ, D, F.G, (int)blockIdx.x);
        pg8::EpiQKV E{QKV, SQ, o_pak, o_pav, o_pbk, o_pbv, o_sak, o_sav, o_sbk, o_sbv, QSCALE};
        pg8::gemm_phase<pg8::EpiQKV, pg8::StaticOrder, true, true>(F.lds + RING_OFF, g, S, E);
    }
    xcd_barrier(bar);
    REFRESH();
    {
        LAS float* tabs = (LAS float*)(F.lds + RING_OFF);
        for (int idx = F.tid; idx < 4 * 8 * 192; idx += NWAVES * 64) {
            const int type = idx / 1536, h = (idx / 192) & 7, i = idx % 192, dist = 159 - i;
            float v = NEGV;
            if (dist >= 0 && dist <= 128) { const int dil = type == 1 ? 4 : (type == 2 ? 16 : 1); v = rel_bias[t5_bucket(dist * dil) * 16 + (type == 3 ? 8 + h : h)] * LOG2E; }
            tabs[idx] = v;
        }
        __syncthreads();
        LAS float* pbuf = (LAS float*)(F.lds + RING_OFF + 32768 + F.wave * 2048);
#ifndef NO_SAMPLE
        for (int st = gw; st < 2 * NS * 8; st += NGW) {
            const bool isB = st >= NS * 8; const int r = isB ? st - NS * 8 : st, n = r >> 3, h = r & 7;
            sample_task(isB, n, h, SQ, rel_bias, sinks, isB ? cache_b_k : cache_a_k, isB ? cache_b_v : cache_a_v, isB ? o_sbk : o_sak, isB ? o_sbv : o_sav, MIX, pbuf);
        }
#endif
#ifndef NO_BAND
        for (int task = gw; task < 4 * 4096; task += NGW) {
            const int type = task >> 12, rem = task & 4095, h = rem & 7, x = rem >> 3, b = x >> 7, y = x & 127;
            const int dil = type == 1 ? 4 : (type == 2 ? 16 : 1);
            const int per = 128 / dil, rc = y / per, qblk = y % per, j0 = 32 * qblk;
            const size_t stride = (size_t)dil * NPROJ;
            const bf16* base = QKV + (size_t)(b * SEQ + rc) * NPROJ;
            const bf16 *Qb, *Kb, *Vb;
            if (type < 3) { Qb = base + h * 64; Kb = base + 512 + h * 64; Vb = base + 1024 + h * 64; }
            else { Qb = base + 1536 + h * 64; Kb = base + 2048 + (h >> 2) * 64; Vb = base + 2176 + (h >> 2) * 64; }
            f32x16 o[2]; float lse2;
            band_task(Qb, Kb, Vb, stride, j0, tabs + (type * 8 + h) * 192, type == 3, type == 3 ? sinks[h] * LOG2E : 0.f, o, lse2);
            const int q = F.lane & 31, hi = F.lane >> 5;
            const int token = b * SEQ + rc + dil * (j0 + q);
            bf16* dst = type < 3 ? OA + ((size_t)type * MP + token) * 512 + h * 64 : MIX + (size_t)token * D + 512 + h * 64;
#pragma unroll
            for (int nb = 0; nb < 2; ++nb)
#pragma unroll
                for (int g4 = 0; g4 < 4; ++g4) { v2u w; w.x = cvtpk(o[nb][4 * g4 + 0], o[nb][4 * g4 + 1]); w.y = cvtpk(o[nb][4 * g4 + 2], o[nb][4 * g4 + 3]);
                    *(v2u*)(dst + 32 * nb + 8 * g4 + 4 * hi) = w; }
            if (type < 3 && hi == 0) LSE[((size_t)type * MP + token) * 8 + h] = lse2;
        }
#endif
    }
    xcd_barrier(bar);
    REFRESH();
    for (int token = gw; token < MP; token += NGW) {
        const int h = F.lane >> 3;
        float l0 = LSE[((size_t)0 * MP + token) * 8 + h], l1 = LSE[((size_t)1 * MP + token) * 8 + h], l2 = LSE[((size_t)2 * MP + token) * 8 + h];
        const float mx = fmaxf(l0, fmaxf(l1, l2));
        float w0 = __builtin_amdgcn_exp2f(l0 - mx), w1 = __builtin_amdgcn_exp2f(l1 - mx), w2 = __builtin_amdgcn_exp2f(l2 - mx);
        const float inv = 1.0f / (w0 + w1 + w2); w0 *= inv; w1 *= inv; w2 *= inv;
        const v4u a0 = ((const v4u*)(OA + ((size_t)0 * MP + token) * 512))[F.lane], a1 = ((const v4u*)(OA + ((size_t)1 * MP + token) * 512))[F.lane], a2 = ((const v4u*)(OA + ((size_t)2 * MP + token) * 512))[F.lane];
        v4u w;
#pragma unroll
        for (int e = 0; e < 4; ++e) {
            const float lo = w0 * bf2f((unsigned short)(a0[e] & 0xffffu)) + w1 * bf2f((unsigned short)(a1[e] & 0xffffu)) + w2 * bf2f((unsigned short)(a2[e] & 0xffffu));
            const float hi_ = w0 * bf2f((unsigned short)(a0[e] >> 16)) + w1 * bf2f((unsigned short)(a1[e] >> 16)) + w2 * bf2f((unsigned short)(a2[e] >> 16));
            w[e] = pk2(lo, hi_);
        }
        ((v4u*)(MIX + (size_t)token * D))[F.lane] = w;
    }
    xcd_barrier(bar);
    REFRESH();
    {
        pg8::Gemm g{MIX, WOUT, M_PAD, D, D, 0, 0, F.wave}; pg8::TailSplitOrder S; S.init(D, 4, F.G, (int)blockIdx.x);
        pg8::EpiF32Z E{Z, SLAB};
        pg8::gemm_phase<pg8::EpiF32Z, pg8::TailSplitOrder, true, true>(F.lds + RING_OFF, g, S, E);
    }
    xcd_barrier(bar);
    REFRESH();
    ln_rows<(FP8_UP ? 2 : 1), 4>(F, X1, X1 + (size_t)MP * D, Z, SLAB, MOD, 5, 1.0f, ln_g + D, ln_b + D, X2, H, 6, 7);
    xcd_barrier(bar);
    REFRESH();
    {
        constexpr int KU = FP8_UP ? D / 2 : D;
        pg8::Gemm g{H, WGU2, M_PAD, 2 * DFF, KU, 0x7f7f7f7f, 0x79797979, F.wave}; pg8::StaticOrder S; S.init(M_PAD, 2 * DFF, KU, F.G, (int)blockIdx.x);
        pg8::EpiSwiGLU<FP8_DOWN> E{ACT, DFF};
        pg8::gemm_phase<pg8::EpiSwiGLU<FP8_DOWN>, pg8::StaticOrder, true, true, FP8_UP>(F.lds + RING_OFF, g, S, E);
    }
    xcd_barrier(bar);
    REFRESH();
    {
        constexpr int KD = FP8_DOWN ? DFF / 2 : DFF;
        pg8::Gemm g{ACT, WD2, M_PAD, D, KD, 0x7c7c7c7c, 0x78787878, F.wave}; pg8::TailSplitOrder S; S.init(KD, FP8_DOWN ? 2 : 4, F.G, (int)blockIdx.x);
        pg8::EpiF32Z E{Z, SLAB};
        pg8::gemm_phase<pg8::EpiF32Z, pg8::TailSplitOrder, true, true, FP8_DOWN>(F.lds + RING_OFF, g, S, E);
    }
    xcd_barrier(bar);
    REFRESH();
    ln_rows<0, 11>(F, X2, X2 + (size_t)MP * D, Z, SLAB, MOD, 8, 0.5f, ln_g + 2 * D, ln_b + 2 * D, OUTP, nullptr, 0, 0);
#ifdef PROBE_SCALE9
    if (blockIdx.x == 0) { for (int i = F.tid; i < 16384; i += NWAVES * 64) o_sbv[i] *= 1.05f; }
#endif
}

#undef IN_
#undef x_prompt
#undef x_sample
#undef cache_a_k
#undef cache_a_v
#undef cache_b_k
#undef cache_b_v
#undef c_prompt
#undef c_sample
#undef rel_bias
#undef w_ada
#undef b_ada
#undef sinks
#undef ln_g
#undef ln_b
#undef OUTP
#undef o_pak
#undef o_pav
#undef o_pbk
#undef o_pbv
#undef o_sak
#undef o_sav
#undef o_sbk
#undef o_sbv
#undef WGU1
#undef WD1
#undef WIN
#undef WOUT
#undef WGU2
#undef WD2
#undef WADA
#undef AMOD
#undef MOD
#undef SQ
#undef H
#undef ACT
#undef Z
#undef X1
#undef X2
#undef QKV
#undef OA
#undef LSE
#undef MIX
#undef SLAB
extern "C" void kernel_launch(void* const* d_in, const int* in_sizes, int n_in, void* d_out, int out_size, void* d_ws, size_t ws_size, hipStream_t stream) {
    static int grid = 0;
    if (grid == 0) {
        if (n_in != 22 || out_size != 25591808 || ws_size < WS_END) { fprintf(stderr, "kernel_launch: unexpected shapes (n_in %d out %d ws %zu)\n", n_in, out_size, ws_size); grid = -1; return; }
        int dev = 0, cus = 0, per_cu = 0;
        if (hipGetDevice(&dev) != hipSuccess || hipDeviceGetAttribute(&cus, hipDeviceAttributeMultiprocessorCount, dev) != hipSuccess) { grid = -1; return; }
        if (hipFuncSetAttribute((const void*)mega_fwd, hipFuncAttributeMaxDynamicSharedMemorySize, LDS_BYTES) != hipSuccess) { fprintf(stderr, "kernel_launch: hipFuncSetAttribute failed\n"); grid = -1; return; }
        if (hipOccupancyMaxActiveBlocksPerMultiprocessor(&per_cu, (const void*)mega_fwd, NWAVES * 64, LDS_BYTES) != hipSuccess || per_cu < 1)
            fprintf(stderr, "kernel_launch: occupancy query reports %d workgroups per CU\n", per_cu);
        (void)hipGetLastError();
        grid = cus;
    }
    if (grid < 0) return;
    if (hipMemsetAsync((char*)d_ws + WS_CTL, 0, CTL_ZERO_BYTES, stream) != hipSuccess) return;
    Args a{};
    for (int i = 0; i < 22; ++i) a.in[i] = (const float*)d_in[i];
    a.out = (float*)d_out; a.ws = (unsigned char*)d_ws;
    hipLaunchKernelGGL(mega_fwd, dim3(grid), dim3(NWAVES * 64), LDS_BYTES, stream, a);
}
```

```cpp
#include <hip/hip_runtime.h>
#include <cstdio>
#include <cstdint>
#include <cstddef>
namespace pg8 {
#define PG8_LAS __attribute__((address_space(3)))
typedef unsigned short bf16_t;
typedef short bf16x8 __attribute__((ext_vector_type(8)));
typedef float f32x4 __attribute__((ext_vector_type(4)));
typedef unsigned u32x4 __attribute__((ext_vector_type(4)));
constexpr int BM = 256, BK = 64, HALF = 128, HTB = HALF * BK * 2  , STAGE_BYTES = 8 * HTB, NXCD = 8, WGM = 8;

__host__ __device__ __forceinline__ int lds_byte(int r, int c) { const int st = (r >> 4) * 2 + (c >> 5), rr = r & 15, cc = c & 31, ob = rr * 64 + cc * 2; return st * 1024 + (ob ^ (((ob >> 9) & 1) << 5)); }
__host__ __device__ __forceinline__ void stage_rc(int b, int& R, int& C) { const int st = b / 1024, sb = b % 1024, swz = sb ^ (((sb >> 9) & 1) << 5); R = (st >> 1) * 16 + swz / 64; C = (st & 1) * 32 + (swz % 64) / 2; }
__host__ __device__ __forceinline__ int perm32(int rho) { const int n = rho >> 4, i = rho & 15; return 8 * (i >> 2) + 4 * n + (i & 3); }

struct Unit { int pm, pn, k0, nt; };
struct Gemm { const bf16_t* A; const bf16_t* Bt; int M, N, K; int sa, sb; int wid; };
__device__ __forceinline__ int fresh_lane() { int z = 0; asm volatile("" : "+v"(z)); return (int)__builtin_amdgcn_mbcnt_hi(~0u, __builtin_amdgcn_mbcnt_lo(~0u, (unsigned)z)); }
typedef int v4i_t __attribute__((ext_vector_type(4)));
typedef int v8i_t __attribute__((ext_vector_type(8)));
template <bool FP8> struct FragT;
template <> struct FragT<false> {
    struct A { bf16x8 k[2]; };
    static __device__ __forceinline__ void load(A& d, const PG8_LAS unsigned char* p) { d.k[0] = *(const PG8_LAS bf16x8*)p; d.k[1] = *(const PG8_LAS bf16x8*)(p + 1024); }
    static __device__ __forceinline__ void mma(f32x4& c, const A& b, const A& a, int, int) { c = __builtin_amdgcn_mfma_f32_16x16x32_bf16(b.k[0], a.k[0], c, 0, 0, 0); c = __builtin_amdgcn_mfma_f32_16x16x32_bf16(b.k[1], a.k[1], c, 0, 0, 0); }
};
template <> struct FragT<true> {
    struct A { v8i_t v; };
    static __device__ __forceinline__ void load(A& d, const PG8_LAS unsigned char* p) { const v4i_t lo = *(const PG8_LAS v4i_t*)p, hi = *(const PG8_LAS v4i_t*)(p + 1024); d.v = __builtin_shufflevector(lo, hi, 0, 1, 2, 3, 4, 5, 6, 7); }
    static __device__ __forceinline__ void mma(f32x4& c, const A& b, const A& a, int sb, int sa) { c = __builtin_amdgcn_mfma_scale_f32_16x16x128_f8f6f4(b.v, a.v, c, 0, 0, 0, sb, 0, sa); }
};

struct StaticOrder {
    int nM, nN, nwg, G, c, ntf;
    __host__ __device__ void init(int M, int N, int K, int G_, int c_) { nM = M / BM; nN = N / BM; nwg = nM * nN; G = G_; c = c_; ntf = K / BK; }
    __host__ __device__ bool next(int i, Unit& u) const {
        const long L = (long)i * G + c; if (L >= nwg) return false;
        int wgid = (int)L; { const int q = nwg / NXCD, r = nwg % NXCD, xcd = wgid % NXCD, off = wgid / NXCD; wgid = (xcd < r ? xcd * (q + 1) : r * (q + 1) + (xcd - r) * q) + off; }
        const int nig = WGM * nN, gid = wgid / nig, fm = gid * WGM, gsz = (nM - fm) < WGM ? (nM - fm) : WGM;
        u.pm = fm + ((wgid % nig) % gsz); u.pn = (wgid % nig) / gsz; u.k0 = 0; u.nt = ntf; return true;
    }
    __device__ __forceinline__ void a_ready(const Unit&) const {}
    __device__ __forceinline__ void done(const Unit&) const {}
};
struct TailSplitOrder {
    StaticOrder so; int nsplit, SL;
    __host__ __device__ void init(int K, int SL_, int G_, int c_) { so.init(64 * BM, 4 * BM, K, G_, c_); SL = SL_; nsplit = 4 * ((K / BK) / SL_); }
    __host__ __device__ bool next(int i, Unit& u) const {
        const long L = (long)i * so.G + so.c;
        if (L < so.nwg) return so.next(i, u);
        const int j = (int)(L - so.nwg); if (j >= nsplit) return false;
        u.pm = 64; u.pn = j & 3; u.k0 = (j >> 2) * SL; u.nt = SL; return true;
    }
    __device__ __forceinline__ void a_ready(const Unit&) const {}
    __device__ __forceinline__ void done(const Unit&) const {}
};
__device__ __forceinline__ unsigned cvt_pk_bf16(float lo, float hi) { unsigned r; asm volatile("v_cvt_pk_bf16_f32 %0, %1, %2" : "=v"(r) : "v"(lo), "v"(hi)); return r; }
typedef float f32x2 __attribute__((ext_vector_type(2)));
typedef float f32x2 __attribute__((ext_vector_type(2)));
struct EpiF32 {
    static constexpr bool PERM = false, AFTER_DRAIN = false;
    float* O; int ldc; const float* bias;
    __device__ __forceinline__ void operator()(const f32x4 (&acc)[2][2][4][2], const Unit& u, int wr, int wc, int fr, int fq) const {
        const int row0 = u.pm * BM + wr * 64 + fr, col0 = u.pn * BM + wc * 32 + 4 * fq;
        f32x4 bv[2][2];
#pragma unroll
        for (int bj = 0; bj < 2; ++bj)
#pragma unroll
            for (int n = 0; n < 2; ++n) bv[bj][n] = bias ? *(const f32x4*)(bias + col0 + bj * HALF + n * 16) : (f32x4){0.f, 0.f, 0.f, 0.f};
#pragma unroll
        for (int ai = 0; ai < 2; ++ai)
#pragma unroll
            for (int m = 0; m < 4; ++m) { float* rowp = O + (size_t)(row0 + ai * HALF + m * 16) * ldc + col0;
#pragma unroll
                for (int bj = 0; bj < 2; ++bj)
#pragma unroll
                    for (int n = 0; n < 2; ++n) *(f32x4*)(rowp + bj * HALF + n * 16) = acc[ai][bj][m][n] + bv[bj][n]; }
    }
};
struct EpiF32Z {
    static constexpr bool PERM = true, AFTER_DRAIN = false;
    float* Z; float* SLAB;
    __device__ __forceinline__ void operator()(const f32x4 (&acc)[2][2][4][2], const Unit& u, int wr, int wc, int fr, int fq) const {
        const int col0 = u.pn * BM + wc * 32 + 8 * fq;
        if (u.pm < 64) {
#pragma unroll
            for (int ai = 0; ai < 2; ++ai)
#pragma unroll
                for (int m = 0; m < 4; ++m) { bf16_t* rowp = (bf16_t*)Z + (size_t)(u.pm * BM + wr * 64 + fr + ai * HALF + m * 16) * 1024 + col0;
#pragma unroll
                    for (int bj = 0; bj < 2; ++bj) { const f32x4 v0 = acc[ai][bj][m][0], v1 = acc[ai][bj][m][1];
                        u32x4 w; w.x = cvt_pk_bf16(v0[0], v0[1]); w.y = cvt_pk_bf16(v0[2], v0[3]); w.z = cvt_pk_bf16(v1[0], v1[1]); w.w = cvt_pk_bf16(v1[2], v1[3]);
                        *(u32x4*)(rowp + bj * HALF) = w; } }
        } else {
            float* sl = SLAB + (size_t)(u.k0 / u.nt) * (128 * 1024);
#pragma unroll
            for (int m = 0; m < 4; ++m) { float* rowp = sl + (size_t)(wr * 64 + fr + m * 16) * 1024 + col0;
#pragma unroll
                for (int bj = 0; bj < 2; ++bj) { *(f32x4*)(rowp + bj * HALF) = acc[0][bj][m][0]; *(f32x4*)(rowp + bj * HALF + 4) = acc[0][bj][m][1]; } }
        }
    }
};
__device__ __forceinline__ float silu_mul(float g, float u) { return g * u * __builtin_amdgcn_rcpf(1.0f + __builtin_amdgcn_exp2f(-1.4426950408889634f * g)); }
__device__ __forceinline__ unsigned pk4_fp8(float a, float b, float c, float d) {
    a = __builtin_amdgcn_fmed3f(a, -448.f, 448.f); b = __builtin_amdgcn_fmed3f(b, -448.f, 448.f); c = __builtin_amdgcn_fmed3f(c, -448.f, 448.f); d = __builtin_amdgcn_fmed3f(d, -448.f, 448.f);
    unsigned w = 0u; w = __builtin_amdgcn_cvt_pk_fp8_f32(a, b, w, false); w = __builtin_amdgcn_cvt_pk_fp8_f32(c, d, w, true); return w; }
template <bool F8OUT> struct EpiSwiGLU {
    static constexpr bool PERM = true, AFTER_DRAIN = false;
    bf16_t* O; int ldc;
    __device__ __forceinline__ void operator()(const f32x4 (&acc)[2][2][4][2], const Unit& u, int wr, int wc, int fr, int fq) const {
        const int row0 = u.pm * BM + wr * 64 + fr, col0 = u.pn * HALF + wc * 32 + 8 * fq;
#pragma unroll
        for (int ai = 0; ai < 2; ++ai)
#pragma unroll
            for (int m = 0; m < 4; ++m) { bf16_t* rowp = O + (size_t)(row0 + ai * HALF + m * 16) * ldc + col0;
                const f32x4 g0 = acc[ai][0][m][0], g1 = acc[ai][0][m][1], u0 = acc[ai][1][m][0], u1 = acc[ai][1][m][1];
                if constexpr (F8OUT) { unsigned char* rp8 = (unsigned char*)O + (size_t)(row0 + ai * HALF + m * 16) * ldc + col0; typedef unsigned u32x2v __attribute__((ext_vector_type(2))); u32x2v w;
                    w.x = pk4_fp8(8.f * silu_mul(g0[0], u0[0]), 8.f * silu_mul(g0[1], u0[1]), 8.f * silu_mul(g0[2], u0[2]), 8.f * silu_mul(g0[3], u0[3]));
                    w.y = pk4_fp8(8.f * silu_mul(g1[0], u1[0]), 8.f * silu_mul(g1[1], u1[1]), 8.f * silu_mul(g1[2], u1[2]), 8.f * silu_mul(g1[3], u1[3]));
                    *(u32x2v*)rp8 = w; }
                else { u32x4 w; w.x = cvt_pk_bf16(silu_mul(g0[0], u0[0]), silu_mul(g0[1], u0[1])); w.y = cvt_pk_bf16(silu_mul(g0[2], u0[2]), silu_mul(g0[3], u0[3]));
                w.z = cvt_pk_bf16(silu_mul(g1[0], u1[0]), silu_mul(g1[1], u1[1])); w.w = cvt_pk_bf16(silu_mul(g1[2], u1[2]), silu_mul(g1[3], u1[3]));
                *(u32x4*)rowp = w; } }
    }
};
struct EpiQKV {
    static constexpr bool PERM = true, AFTER_DRAIN = false;
    bf16_t* O;
    float* sq;
    float *pak, *pav, *pbk, *pbv, *sak, *sav, *sbk, *sbv;
    float qscale;
    __device__ __forceinline__ void operator()(const f32x4 (&acc)[2][2][4][2], const Unit& u, int wr, int wc, int fr, int fq) const {
        const int pn = u.pn;
#pragma unroll
        for (int ai = 0; ai < 2; ++ai)
#pragma unroll
            for (int m = 0; m < 4; ++m) { const int row = u.pm * BM + ai * HALF + wr * 64 + m * 16 + fr;
#pragma unroll
                for (int bj = 0; bj < 2; ++bj) { const int col = pn * BM + bj * HALF + wc * 32 + 8 * fq;
                    f32x4 v0 = acc[ai][bj][m][0], v1 = acc[ai][bj][m][1];
                    const bool isq = (pn < 2) || (pn == 6) || (pn == 7);
                    if (isq) { v0 = v0 * qscale; v1 = v1 * qscale; }
                    u32x4 w; w.x = cvt_pk_bf16(v0[0], v0[1]); w.y = cvt_pk_bf16(v0[2], v0[3]); w.z = cvt_pk_bf16(v1[0], v1[1]); w.w = cvt_pk_bf16(v1[2], v1[3]);
                    *(u32x4*)(O + (size_t)row * 2304 + col) = w;
                    float* dst = nullptr;
                    if (row < 16384) { const int b = row >> 12, t = row & 4095;
                        if (pn == 2 || pn == 3) { if (t >= 2048) dst = pak + ((size_t)(b * 2048 + t - 2048)) * 512 + (col - 512); }
                        else if (pn == 4 || pn == 5) { if (t >= 2048) dst = pav + ((size_t)(b * 2048 + t - 2048)) * 512 + (col - 1024); }
                        else if (pn == 8) { if (t >= 3968) dst = (bj == 0 ? pbk : pbv) + ((size_t)(b * 128 + t - 3968)) * 128 + (col - 2048 - bj * 128); }
                    } else if (row < 16512) { const int n = row - 16384;
                        if (pn < 2) dst = sq + (size_t)n * 1024 + col;
                        else if (pn == 2 || pn == 3) dst = sak + (size_t)n * 512 + (col - 512);
                        else if (pn == 4 || pn == 5) dst = sav + (size_t)n * 512 + (col - 1024);
                        else if (pn == 6 || pn == 7) dst = sq + (size_t)n * 1024 + 512 + (col - 1536);
                        else dst = (bj == 0 ? sbk : sbv) + (size_t)n * 128 + (col - 2048 - bj * 128);
                    }
                    if (dst) { *(f32x4*)dst = v0; *(f32x4*)(dst + 4) = v1; }
                } }
    }
};
template <class Epi, class Sched, bool ALIGN_EPI = false, bool SP2 = false, bool FP8 = false>
__device__ __forceinline__ void gemm_phase(PG8_LAS unsigned char* lds, const Gemm g, const Sched& S, const Epi& E) {
    const int wid = g.wid, lane = fresh_lane(), tid = wid * 64 + lane;
    const int wr = wid >> 2, wc = wid & 3, fr = lane & 15, fq = lane >> 4;
    const int K = g.K;
    unsigned voffA[2], voffB[2];
#pragma unroll
    for (int i = 0; i < 2; ++i) { int R, C; stage_rc(tid * 16 + i * 8192, R, C); const int Rb = Epi::PERM ? ((R & ~31) + perm32(R & 31)) : R;
        voffA[i] = (unsigned)(R * K + C) * 2u; voffB[i] = (unsigned)(Rb * K + C) * 2u; }
    const unsigned kstep = (unsigned)(BK * 2);
    const unsigned hstep = (unsigned)HALF * K * 2;
    const unsigned tstep = 2 * hstep;
    const unsigned ldsw = (unsigned)wid * 1024u;
    const int aoff = lds_byte(wr * 64 + fr, fq * 8), boff = lds_byte(wc * 32 + fr, fq * 8);
#define PG8_SA(b, h) (((b) * 2 + (h)) * HTB)
#define PG8_SB(b, h) ((4 + (b) * 2 + (h)) * HTB)
    const __amdgpu_buffer_rsrc_t rsA = __builtin_amdgcn_make_buffer_rsrc((void*)g.A, 0, 0x7fffffff, 0x00020000), rsB = __builtin_amdgcn_make_buffer_rsrc((void*)g.Bt, 0, 0x7fffffff, 0x00020000);
#define PG8_RS_voffA rsA
#define PG8_RS_voffB rsB
#define PG8_STAGE(bufoff, goff, voff) do { _Pragma("unroll") for (int _i = 0; _i < 2; ++_i) \
        __builtin_amdgcn_raw_ptr_buffer_load_lds(PG8_RS_##voff, (PG8_LAS void*)(lds + (bufoff) + ldsw + _i * 8192), 16, (voff)[_i], (int)(goff), 0, 0); } while (0)
#define PG8_LDA(dst, b, h) do { _Pragma("unroll") for (int m = 0; m < 4; ++m) FragT<FP8>::load(dst[m], lds + PG8_SA(b, h) + aoff + m * 2048); } while (0)
#define PG8_LDB(dst, b, h) do { _Pragma("unroll") for (int n = 0; n < 2; ++n) FragT<FP8>::load(dst[n], lds + PG8_SB(b, h) + boff + n * 2048); } while (0)
#define PG8_MMA(ai, bj, At, Bt) do { __builtin_amdgcn_s_setprio(1); \
        _Pragma("unroll") for (int m = 0; m < 4; ++m) _Pragma("unroll") for (int n = 0; n < 2; ++n) FragT<FP8>::mma(acc[ai][bj][m][n], Bt[n], At[m], g.sb, g.sa); \
        __builtin_amdgcn_s_setprio(0); } while (0)
#define PG8_WAIT_V(n) asm volatile("s_waitcnt vmcnt(" #n ")" ::: "memory")
#define PG8_WAIT_L(n) asm volatile("s_waitcnt lgkmcnt(" #n ")" ::: "memory")
#define PG8_BAR __builtin_amdgcn_s_barrier()
#define PG8_SCHED __builtin_amdgcn_sched_barrier(0)
    Unit cur, nxt; int ui = 0;
    if (!S.next(0, cur)) return;
    f32x4 acc[2][2][4][2];
#pragma unroll
    for (int a = 0; a < 2; ++a)
#pragma unroll
        for (int b = 0; b < 2; ++b)
#pragma unroll
            for (int m = 0; m < 4; ++m)
#pragma unroll
                for (int n = 0; n < 2; ++n) acc[a][b][m][n] = (f32x4){0.f, 0.f, 0.f, 0.f};
    typename FragT<FP8>::A At[4]; typename FragT<FP8>::A B0[2], B1[2];
    unsigned cA = (unsigned)cur.pm * tstep + (unsigned)cur.k0 * kstep; unsigned cB = (unsigned)cur.pn * tstep + (unsigned)cur.k0 * kstep;
    S.a_ready(cur);
    if constexpr (SP2) {
        PG8_STAGE(PG8_SB(0, 0), cB, voffB); PG8_STAGE(PG8_SB(0, 1), cB + hstep, voffB); PG8_STAGE(PG8_SA(0, 0), cA, voffA); PG8_STAGE(PG8_SA(0, 1), cA + hstep, voffA);
        if (wr == 1) PG8_BAR;
        PG8_WAIT_V(2); PG8_BAR;
        PG8_STAGE(PG8_SB(1, 0), cB + kstep, voffB); PG8_STAGE(PG8_SA(1, 0), cA + kstep, voffA); PG8_STAGE(PG8_SB(1, 1), cB + hstep + kstep, voffB);
        PG8_WAIT_V(6); PG8_BAR;
    } else {
        PG8_STAGE(PG8_SB(0, 0), cB, voffB); PG8_STAGE(PG8_SA(0, 0), cA, voffA); PG8_STAGE(PG8_SB(0, 1), cB + hstep, voffB); PG8_STAGE(PG8_SA(0, 1), cA + hstep, voffA);
        if (wr == 1) PG8_BAR;
        PG8_WAIT_V(4); PG8_BAR;
        PG8_STAGE(PG8_SB(1, 0), cB + kstep, voffB); PG8_STAGE(PG8_SA(1, 0), cA + kstep, voffA); PG8_STAGE(PG8_SB(1, 1), cB + hstep + kstep, voffB);
        PG8_WAIT_V(6); PG8_BAR;
    }
    for (;;) {
        const bool has_next = S.next(ui + 1, nxt);
        const unsigned nA = has_next ? (unsigned)nxt.pm * tstep + (unsigned)nxt.k0 * kstep : cA; const unsigned nB = has_next ? (unsigned)nxt.pn * tstep + (unsigned)nxt.k0 * kstep : cB;
        const int nt = cur.nt;
        for (int t = 0; t < nt; t += 2) {
            const bool last = (t == nt - 2);
            const unsigned a1 = cA + (unsigned)(t + 1) * kstep;
            const unsigned a2 = last ? nA : cA + (unsigned)(t + 2) * kstep; const unsigned b2 = last ? nB : cB + (unsigned)(t + 2) * kstep;
            const unsigned a3 = a2 + kstep; const unsigned b3 = b2 + kstep;
            if (last && has_next) S.a_ready(nxt);
            if constexpr (SP2) {
            PG8_LDB(B0, 0, 0); PG8_LDB(B1, 0, 1); PG8_SCHED; PG8_LDA(At, 0, 0); PG8_STAGE(PG8_SA(1, 1), a1 + hstep, voffA);
            PG8_WAIT_V(8); PG8_WAIT_L(0); PG8_BAR; PG8_MMA(0, 0, At, B0); PG8_MMA(0, 1, At, B1); PG8_BAR; PG8_SCHED;
            PG8_LDA(At, 0, 1); PG8_STAGE(PG8_SB(0, 0), b2, voffB); PG8_STAGE(PG8_SB(0, 1), b2 + hstep, voffB); PG8_STAGE(PG8_SA(0, 0), a2, voffA);
            PG8_WAIT_V(8); PG8_WAIT_L(0); PG8_BAR; PG8_MMA(1, 0, At, B0); PG8_MMA(1, 1, At, B1); PG8_BAR; PG8_SCHED;
            PG8_LDB(B0, 1, 0); PG8_LDB(B1, 1, 1); PG8_SCHED; PG8_LDA(At, 1, 0); PG8_STAGE(PG8_SA(0, 1), a2 + hstep, voffA);
            PG8_WAIT_V(8); PG8_WAIT_L(0); PG8_BAR; PG8_MMA(0, 0, At, B0); PG8_MMA(0, 1, At, B1); PG8_BAR; PG8_SCHED;
            PG8_LDA(At, 1, 1); PG8_STAGE(PG8_SB(1, 0), b3, voffB); PG8_STAGE(PG8_SB(1, 1), b3 + hstep, voffB); PG8_STAGE(PG8_SA(1, 0), a3, voffA);
            PG8_WAIT_V(8); PG8_WAIT_L(0); PG8_BAR; PG8_MMA(1, 0, At, B0); PG8_MMA(1, 1, At, B1); PG8_BAR; PG8_SCHED;
            } else {
            PG8_LDB(B0, 0, 0); PG8_SCHED; PG8_LDA(At, 0, 0); PG8_STAGE(PG8_SA(1, 1), a1 + hstep, voffA);
            PG8_WAIT_L(8); PG8_BAR; PG8_WAIT_L(0); PG8_MMA(0, 0, At, B0); PG8_BAR; PG8_SCHED;
            PG8_LDB(B1, 0, 1); PG8_STAGE(PG8_SB(0, 0), b2, voffB);
            PG8_BAR; PG8_WAIT_L(0); PG8_MMA(0, 1, At, B1); PG8_BAR;
            PG8_LDA(At, 0, 1); PG8_STAGE(PG8_SA(0, 0), a2, voffA);
            PG8_BAR; PG8_WAIT_L(0); PG8_MMA(1, 0, At, B0); PG8_BAR; PG8_SCHED;
            PG8_STAGE(PG8_SB(0, 1), b2 + hstep, voffB);
            PG8_WAIT_V(6); PG8_BAR; PG8_MMA(1, 1, At, B1); PG8_BAR;
            PG8_LDB(B0, 1, 0); PG8_SCHED; PG8_LDA(At, 1, 0); PG8_STAGE(PG8_SA(0, 1), a2 + hstep, voffA);
            PG8_WAIT_L(8); PG8_BAR; PG8_WAIT_L(0); PG8_MMA(0, 0, At, B0); PG8_BAR; PG8_SCHED;
            PG8_LDB(B1, 1, 1); PG8_STAGE(PG8_SB(1, 0), b3, voffB);
            PG8_BAR; PG8_WAIT_L(0); PG8_MMA(0, 1, At, B1); PG8_BAR;
            PG8_LDA(At, 1, 1); PG8_STAGE(PG8_SA(1, 0), a3, voffA);
            PG8_BAR; PG8_WAIT_L(0); PG8_MMA(1, 0, At, B0); PG8_BAR; PG8_SCHED;
            PG8_STAGE(PG8_SB(1, 1), b3 + hstep, voffB);
            PG8_WAIT_V(6); PG8_BAR; PG8_MMA(1, 1, At, B1); PG8_BAR;
            }
        }
        if constexpr (ALIGN_EPI) { if (wr == 0) PG8_BAR; }
        if constexpr (!Epi::AFTER_DRAIN) { const int l2_ = fresh_lane(); const int fr_ = l2_ & 15, fq_ = l2_ >> 4;
            E(acc, cur, wr, wc, fr_, fq_); S.done(cur); }
        if (!has_next) break;
#pragma unroll
        for (int a = 0; a < 2; ++a)
#pragma unroll
            for (int b = 0; b < 2; ++b)
#pragma unroll
                for (int m = 0; m < 4; ++m)
#pragma unroll
                    for (int n = 0; n < 2; ++n) acc[a][b][m][n] = (f32x4){0.f, 0.f, 0.f, 0.f};
        cur = nxt; cA = nA; cB = nB; ++ui;
        if constexpr (ALIGN_EPI) { if (wr == 1) PG8_BAR; }
    }
    PG8_WAIT_V(0);
    if constexpr (!ALIGN_EPI) { if (wr == 0) PG8_BAR; }
    PG8_BAR;
    if constexpr (Epi::AFTER_DRAIN) { E.fused(acc, cur, wr, wc, fr, fq, lds, wid, lane); S.done(cur); }
#undef PG8_SA
#undef PG8_SB
#undef PG8_STAGE
#undef PG8_RS_voffA
#undef PG8_RS_voffB
#undef PG8_LDA
#undef PG8_LDB
#undef PG8_MMA
#undef PG8_WAIT_V
#undef PG8_WAIT_L
#undef PG8_BAR
#undef PG8_SCHED
}
}
constexpr int D = 1024, DFF = 2816, NPROJ = 2304, SEQ = 4096, NBATCH = 4, MP = NBATCH * SEQ, NS = 128, M_REAL = MP + NS, M_PAD = 16640;
constexpr int NMOD = 9 * D;
constexpr float LN_EPS = 1e-5f;
constexpr float ALPHA = 1.189207115002721f;
constexpr float LOG2E = 1.4426950408889634f;
constexpr float QSCALE = 0.125f * LOG2E;
constexpr float NEGV = -1e30f;
constexpr int NWAVES = 8;
#ifndef FP8_UP
#define FP8_UP true
#endif
#ifndef FP8_DOWN
#define FP8_DOWN true
#endif

constexpr size_t MiB = 1u << 20;
constexpr size_t WS_CTL = 0, CTL_ZERO_BYTES = 1 * MiB;
constexpr size_t WS_WGU1 = 2 * MiB, WS_WD1 = 13 * MiB, WS_WIN = 19 * MiB, WS_WOUT = 24 * MiB, WS_WGU2 = 26 * MiB, WS_WD2 = 37 * MiB, WS_WADA = 43 * MiB;
constexpr size_t WS_AMOD = 61 * MiB, WS_MOD = 62 * MiB, WS_SQ = 71 * MiB + 512 * 1024, WS_H = 72 * MiB, WS_ACT = 105 * MiB, WS_Z = 195 * MiB, WS_X1 = 260 * MiB, WS_X2 = 325 * MiB;
constexpr size_t WS_QKV = 390 * MiB, WS_OA = 464 * MiB, WS_LSE = 512 * MiB, WS_MIX = 514 * MiB, WS_SLAB = 548 * MiB, WS_END = 554 * MiB;
static_assert(WS_MOD + (size_t)256 * NMOD * 4 <= WS_SQ && WS_SQ + (size_t)NS * 1024 * 4 <= WS_H && WS_H + (size_t)M_PAD * D * 2 <= WS_ACT && WS_ACT + (size_t)M_PAD * DFF * 2 <= WS_Z, "ws map 1");
static_assert(WS_Z + (size_t)M_PAD * D * 4 <= WS_X1 && WS_QKV + (size_t)M_PAD * NPROJ * 2 <= WS_OA && WS_OA + (size_t)3 * MP * 512 * 2 <= WS_LSE && WS_LSE + (size_t)3 * MP * 8 * 4 <= WS_MIX && WS_MIX + (size_t)M_PAD * D * 2 <= WS_SLAB && WS_SLAB + (size_t)11 * 128 * 1024 * 4 <= WS_END, "ws map 2");
constexpr int CW_BAR = 4096;

constexpr int RING_OFF = 0, RING_BYTES = 131072;
constexpr int LDSCTL_OFF = RING_BYTES, MISC_OFF = LDSCTL_OFF + 320;
constexpr int LDS_BYTES = 147456;

#define GAS __attribute__((address_space(1)))
#define LAS __attribute__((address_space(3)))
typedef unsigned short bf16;
typedef unsigned v4u __attribute__((ext_vector_type(4)));
typedef unsigned v2u __attribute__((ext_vector_type(2)));
typedef float f32x4 __attribute__((ext_vector_type(4)));
typedef short bf16x8 __attribute__((ext_vector_type(8)));
typedef float f32x16 __attribute__((ext_vector_type(16)));
typedef GAS unsigned gu32;
#define RLX_AGENT __ATOMIC_RELAXED, __HIP_MEMORY_SCOPE_AGENT
#define LDS_WAIT() asm volatile("s_waitcnt lgkmcnt(0)" ::: "memory")
__device__ __forceinline__ unsigned f2bf(float f) { unsigned u = __builtin_bit_cast(unsigned, f); return (u + 0x7fffu + ((u >> 16) & 1u)) >> 16; }
__device__ __forceinline__ unsigned pk2(float lo, float hi) { return f2bf(lo) | (f2bf(hi) << 16); }
__device__ __forceinline__ float bf2f(unsigned short b) { return __builtin_bit_cast(float, (unsigned)b << 16); }
#define XB_TMO      128
#define XB_XCNT(j)  (256  + 64 * (j))
#define XB_XSUB(j)  (1280 + 64 * (j))
#define XB_XGEN(j)  (2304 + 64 * (j))
#define XB_TOP      3328
#define XB_TOPGEN   3392
#define XCD_BAR_WORDS 3456
#define XB_SPIN_CAP (1u << 18)

__device__ __forceinline__ unsigned xb_ld(unsigned* p)              { return __hip_atomic_load(p, __ATOMIC_RELAXED, __HIP_MEMORY_SCOPE_AGENT); }
__device__ __forceinline__ unsigned xb_add(unsigned* p, unsigned v) { return __hip_atomic_fetch_add(p, v, __ATOMIC_RELAXED, __HIP_MEMORY_SCOPE_AGENT); }
__device__ __forceinline__ unsigned xb_xcc_id() { return (unsigned)__builtin_amdgcn_s_getreg((3 << 11) | 20) & 0xFu; }
#define XB_SPIN(cond, bar) do { unsigned _sp = 0; while (cond) { __builtin_amdgcn_s_sleep(1); \
    if ((++_sp & 255u) == 0u) { if (xb_ld(&(bar)[XB_TMO])) break; if (_sp > XB_SPIN_CAP) { atomicAdd(&(bar)[XB_TMO], 1u); break; } } } } while (0)

struct XcdBarrier {
    unsigned* bar; unsigned x;
    volatile LAS unsigned* st;
};

__device__ __forceinline__ XcdBarrier xcd_barrier_post(unsigned* bar, volatile LAS unsigned* st) {
    XcdBarrier b; b.bar = bar; b.x = xb_xcc_id(); b.st = st;
    if (threadIdx.x == 0) (void)xb_add(&bar[XB_XCNT(b.x)], 1u);
    return b;
}
__device__ __forceinline__ void xcd_barrier_complete(unsigned* bar, unsigned x, unsigned& nloc, unsigned& nx) {
    const unsigned G = gridDim.x * gridDim.y * gridDim.z;
    unsigned sum, cnt, mine, sp = 0u;
    for (;;) {
        sum = 0u; cnt = 0u; mine = 0u;
#pragma unroll
        for (unsigned j = 0; j < 16; ++j) { const unsigned c = xb_ld(&bar[XB_XCNT(j)]); sum += c; cnt += (c > 0u) ? 1u : 0u; mine = (j == x) ? c : mine; }
        if (sum == G) break;
        __builtin_amdgcn_s_sleep(1);
        if ((++sp & 255u) == 0u) { if (xb_ld(&bar[XB_TMO])) break; if (sp > XB_SPIN_CAP) { atomicAdd(&bar[XB_TMO], 1u); break; } }
    }
    nloc = mine > 0u ? mine : 1u; nx = cnt > 0u ? cnt : 1u;
}

__device__ __forceinline__ void xcd_barrier(const XcdBarrier& b) {
    asm volatile("s_waitcnt vmcnt(0)" ::: "memory");
    __syncthreads();
    if (threadIdx.x == 0) {
        unsigned* bar = b.bar;
        __builtin_amdgcn_s_waitcnt(0);
        unsigned nloc = b.st[0], nx = b.st[1];
        if (nloc == 0u) { xcd_barrier_complete(bar, b.x, nloc, nx); b.st[0] = nloc; b.st[1] = nx; }
        const unsigned old = xb_add(&bar[XB_XSUB(b.x)], 1u);
        const unsigned gen = old / nloc;
        if (old + 1u == (gen + 1u) * nloc) {
            __builtin_amdgcn_fence(__ATOMIC_RELEASE, "agent");
            asm volatile("s_waitcnt vmcnt(0)" ::: "memory");
            const unsigned og = xb_add(&bar[XB_TOP], 1u);
            const unsigned tg = og / nx;
            if (og + 1u == (tg + 1u) * nx) xb_add(&bar[XB_TOPGEN], 1u);
            else XB_SPIN(xb_ld(&bar[XB_TOPGEN]) == tg, bar);
            __builtin_amdgcn_fence(__ATOMIC_ACQUIRE, "agent");
            xb_add(&bar[XB_XGEN(b.x)], 1u);
            asm volatile("s_waitcnt vmcnt(0)" ::: "memory");
        } else {
            XB_SPIN(xb_ld(&bar[XB_XGEN(b.x)]) == gen, bar);
            __builtin_amdgcn_fence(__ATOMIC_ACQUIRE, "agent");
            asm volatile("s_waitcnt vmcnt(0)" ::: "memory");
        }
    }
    __syncthreads();
}
struct Args { const float* in[22]; float* out; unsigned char* ws; };
struct Frame {
    LAS unsigned char* lds;
    int tid, lane, wave, vcu, G;
};
__device__ __forceinline__ float wave_sum(float v) {
#pragma unroll
    for (int o = 1; o < 64; o <<= 1) v += __shfl_xor(v, o);
    return v;
}
__device__ __forceinline__ float wave_max(float v) {
#pragma unroll
    for (int o = 1; o < 64; o <<= 1) v = fmaxf(v, __shfl_xor(v, o));
    return v;
}
template <bool F8>
__device__ __forceinline__ void p0_transpose_item(const float* W, int K, int N, bf16* WT, int k0, int n0, int drow0, float wscale, LAS float* scr, int lane) {
#pragma unroll 8
    for (int i = 0; i < 32; ++i) { const int kk = 2 * i + (lane >> 5); scr[kk * 33 + (lane & 31)] = W[(size_t)(k0 + kk) * N + n0 + (lane & 31)]; }
    LDS_WAIT(); asm volatile("" ::: "memory");
    const int c = lane & 7;
#pragma unroll
    for (int j = 0; j < 4; ++j) { const int n = (lane >> 3) + 8 * j; const LAS float* s = scr + (8 * c) * 33 + n;
        if constexpr (F8) { v2u o; o.x = pg8::pk4_fp8(s[0 * 33] * wscale, s[1 * 33] * wscale, s[2 * 33] * wscale, s[3 * 33] * wscale); o.y = pg8::pk4_fp8(s[4 * 33] * wscale, s[5 * 33] * wscale, s[6 * 33] * wscale, s[7 * 33] * wscale);
            *(GAS v2u*)((unsigned char*)WT + (size_t)(drow0 + n) * K + k0 + 8 * c) = o; }
        else { v4u o; o.x = pk2(s[0 * 33], s[1 * 33]); o.y = pk2(s[2 * 33], s[3 * 33]); o.z = pk2(s[4 * 33], s[5 * 33]); o.w = pk2(s[6 * 33], s[7 * 33]);
        *(GAS v4u*)(WT + (size_t)(drow0 + n) * K + k0 + 8 * c) = o; } }
    LDS_WAIT(); asm volatile("" ::: "memory");
}
template <bool GU, bool F8>
__device__ __forceinline__ bool p0_matrix(int& r, const float* W, int K, int N, bf16* WT, int half, float wscale, LAS float* scr, int lane) {
    const int nblk = N / 32, items = (K / 64) * nblk;
    if (r >= items) { r -= items; return false; }
    const int kb = r / nblk, nb = r % nblk, n0 = 32 * nb;
    const int drow0 = GU ? (256 * (n0 >> 7) + (n0 & 127) + half * 128) : n0;
    p0_transpose_item<F8>(W, K, N, WT, 64 * kb, n0, drow0, wscale, scr, lane);
    return true;
}
__device__ __forceinline__ int seq_of_row(int row) { return row < MP ? (row >> 12) : (4 + row - MP); }

typedef float f32x2_t __attribute__((ext_vector_type(2))); typedef __bf16 bf16x2_t __attribute__((ext_vector_type(2)));
__device__ __forceinline__ unsigned cvtpk(float lo, float hi) { f32x2_t v = {lo, hi}; bf16x2_t b = __builtin_convertvector(v, bf16x2_t); return __builtin_bit_cast(unsigned, b); }
#define PACK8(X, S) __builtin_bit_cast(bf16x8, (v4u){cvtpk((X)[8 * (S) + 0], (X)[8 * (S) + 1]), cvtpk((X)[8 * (S) + 2], (X)[8 * (S) + 3]), cvtpk((X)[8 * (S) + 4], (X)[8 * (S) + 5]), cvtpk((X)[8 * (S) + 6], (X)[8 * (S) + 7])})
__device__ __forceinline__ int t5_bucket(int n) {
    if (n < 16) return n;
    int b = 16;
    b += (n >= 22); b += (n >= 30); b += (n >= 40); b += (n >= 54); b += (n >= 73); b += (n >= 99); b += (n >= 134); b += (n >= 182);
    b += (n >= 246); b += (n >= 332); b += (n >= 450); b += (n >= 609); b += (n >= 825); b += (n >= 1117); b += (n >= 1513);
    return b;
}
__device__ __forceinline__ void band_task(const bf16* Qb, const bf16* Kb, const bf16* Vb, size_t stride, int j0, const LAS float* tab, bool has_sink, float sink2,
                                          f32x16 (&o)[2], float& lse2) {
    const int lane = pg8::fresh_lane(), q = lane & 31, hi = lane >> 5;
    const int pr = (q & ~12) | ((q & 4) << 1) | ((q & 8) >> 1);
    const int tb = 8 * hi - q + 31;
    bf16x8 qf[4], kf[5][4];
    { const bf16* qrow = Qb + (size_t)(j0 + q) * stride + 8 * hi;
#pragma unroll
      for (int d0 = 0; d0 < 4; ++d0) qf[d0] = *(const bf16x8*)(qrow + 16 * d0); }
#pragma unroll
    for (int kt = 0; kt < 5; ++kt) {
        int jj = j0 - 128 + 32 * kt + pr; jj = jj < 0 ? 0 : jj;
        const bf16* krow = Kb + (size_t)jj * stride + 8 * hi;
#pragma unroll
        for (int d0 = 0; d0 < 4; ++d0) kf[kt][d0] = *(const bf16x8*)(krow + 16 * d0);
    }
    f32x16 s[5];
#pragma unroll
    for (int kt = 0; kt < 5; ++kt) {
        f32x16 c;
#pragma unroll
        for (int r = 0; r < 16; ++r) c[r] = tab[tb + 32 * kt + 16 * (r >> 3) + (r & 7)];
#pragma unroll
        for (int d0 = 0; d0 < 4; ++d0) c = __builtin_amdgcn_mfma_f32_32x32x16_bf16(kf[kt][d0], qf[d0], c, 0, 0, 0);
        if (j0 < 128) {
#pragma unroll
            for (int r = 0; r < 16; ++r) { const int jr = j0 - 128 + 32 * kt + 16 * (r >> 3) + 8 * hi + (r & 7); if (jr < 0) c[r] = NEGV; }
        }
        s[kt] = c;
    }
    bf16x8 vf[5][4];
#pragma unroll
    for (int kt = 0; kt < 5; ++kt) {
        int jj = j0 - 128 + 32 * kt + pr; jj = jj < 0 ? 0 : jj;
        const bf16* vrow = Vb + (size_t)jj * stride + 8 * hi;
#pragma unroll
        for (int d0 = 0; d0 < 4; ++d0) vf[kt][d0] = *(const bf16x8*)(vrow + 16 * d0);
    }
    float m = s[0][0];
#pragma unroll
    for (int kt = 0; kt < 5; ++kt)
#pragma unroll
        for (int r = 0; r < 16; ++r) m = fmaxf(m, s[kt][r]);
    m = fmaxf(m, __shfl_xor(m, 32));
    if (has_sink) m = fmaxf(m, sink2);
    float den = 0.f;
#pragma unroll
    for (int kt = 0; kt < 5; ++kt)
#pragma unroll
        for (int r = 0; r < 16; ++r) { const float p = __builtin_amdgcn_exp2f(s[kt][r] - m); s[kt][r] = p; den += p; }
    den += __shfl_xor(den, 32);
    if (has_sink) den += __builtin_amdgcn_exp2f(sink2 - m);
    bf16x8 I0, I1;
#pragma unroll
    for (int j = 0; j < 8; ++j) { const bool on = (((q >> 3) & 1) == hi) && ((q & 7) == j);
        I0[j] = (on && (q >> 4) == 0) ? (short)0x3F80 : (short)0; I1[j] = (on && (q >> 4) == 1) ? (short)0x3F80 : (short)0; }
    o[0] = (f32x16){}; o[1] = (f32x16){};
#pragma unroll
    for (int kt = 0; kt < 5; ++kt) {
        f32x16 X0 = (f32x16){}, X1 = (f32x16){};
        X0 = __builtin_amdgcn_mfma_f32_32x32x16_bf16(vf[kt][0], I0, X0, 0, 0, 0); X0 = __builtin_amdgcn_mfma_f32_32x32x16_bf16(vf[kt][1], I1, X0, 0, 0, 0);
        X1 = __builtin_amdgcn_mfma_f32_32x32x16_bf16(vf[kt][2], I0, X1, 0, 0, 0); X1 = __builtin_amdgcn_mfma_f32_32x32x16_bf16(vf[kt][3], I1, X1, 0, 0, 0);
        { const bf16x8 pa = PACK8(s[kt], 0); o[0] = __builtin_amdgcn_mfma_f32_32x32x16_bf16(PACK8(X0, 0), pa, o[0], 0, 0, 0); o[1] = __builtin_amdgcn_mfma_f32_32x32x16_bf16(PACK8(X1, 0), pa, o[1], 0, 0, 0); }
        { const bf16x8 pa = PACK8(s[kt], 1); o[0] = __builtin_amdgcn_mfma_f32_32x32x16_bf16(PACK8(X0, 1), pa, o[0], 0, 0, 0); o[1] = __builtin_amdgcn_mfma_f32_32x32x16_bf16(PACK8(X1, 1), pa, o[1], 0, 0, 0); }
    }
    const float inv = 1.0f / den;
#pragma unroll
    for (int r = 0; r < 16; ++r) { o[0][r] *= inv; o[1][r] *= inv; }
    lse2 = m + __builtin_log2f(den);
}
__device__ __forceinline__ void sample_task(bool isB, int n, int h, const float* sq, const float* rel_bias, const float* sinks,
                                            const float* cache_k, const float* cache_v, const float* own_k, const float* own_v, bf16* mix, LAS float* pbuf) {
    const int lane = pg8::fresh_lane();
    f32x4 qv[16];
    { const f32x4* qp = (const f32x4*)(sq + (size_t)n * 1024 + (isB ? 512 : 0) + h * 64);
#pragma unroll
      for (int i = 0; i < 16; ++i) qv[i] = qp[i]; }
    const int nvis = isB ? 129 : 321, npass = isB ? 3 : 6;
    const int rowstride = isB ? 128 : 512, nrows = isB ? 128 : 2048, hcol = isB ? (h >> 2) * 64 : h * 64;
    const float* ck = cache_k + (size_t)n * nrows * rowstride + hcol;
    const float* cv = cache_v + (size_t)n * nrows * rowstride + hcol;
    const float* ok = own_k + (size_t)n * rowstride + hcol;
    const float* ov = own_v + (size_t)n * rowstride + hcol;
    const int bcol = isB ? 8 + h : h;
    float lmax = NEGV;
#pragma unroll 2
    for (int pass = 0; pass < npass; ++pass) {
        const int v = pass * 64 + lane; const bool valid = v < nvis;
        int dl = isB ? v : (v < 129 ? v : (v < 225 ? 128 + 4 * (v - 128) : 512 + 16 * (v - 224)));
        if (!valid) dl = 0;
        const f32x4* kp = (const f32x4*)(dl == 0 ? ok : ck + (size_t)(nrows - dl) * rowstride);
        float dot = 0.f;
#pragma unroll
        for (int i = 0; i < 16; ++i) { const f32x4 kk = kp[i]; dot += (kk[0] * qv[i][0] + kk[1] * qv[i][1]) + (kk[2] * qv[i][2] + kk[3] * qv[i][3]); }
        float lm = 0.f;
        if (!isB) { const int mult = (dl <= 128 ? 1 : 0) + ((dl <= 512 && (dl & 3) == 0) ? 1 : 0) + ((dl & 15) == 0 ? 1 : 0); lm = mult == 3 ? 1.5849625007211562f : (mult == 2 ? 1.0f : 0.f); }
        float s = dot + rel_bias[t5_bucket(dl) * 16 + bcol] * LOG2E + lm;
        s = valid ? s : NEGV;
        pbuf[v] = s; lmax = fmaxf(lmax, s);
    }
    float m = wave_max(lmax);
    const float sink2 = isB ? sinks[h] * LOG2E : NEGV;
    if (isB) m = fmaxf(m, sink2);
    float den = 0.f;
    LDS_WAIT(); asm volatile("" ::: "memory");
#pragma unroll 1
    for (int pass = 0; pass < npass; ++pass) { const int v = pass * 64 + lane; const float p = __builtin_amdgcn_exp2f(pbuf[v] - m); den += p; pbuf[v] = p; }
    den = wave_sum(den);
    if (isB) den += __builtin_amdgcn_exp2f(sink2 - m);
    LDS_WAIT(); asm volatile("" ::: "memory");
    const int dch = lane & 15, g = lane >> 4;
    f32x4 acc = (f32x4){0.f, 0.f, 0.f, 0.f};
    const int nit = (nvis + 3) >> 2;
#pragma unroll 16
    for (int it = 0; it < nit; ++it) {
        const int v = 4 * it + g;
        if (v < nvis) {
            const int dl = isB ? v : (v < 129 ? v : (v < 225 ? 128 + 4 * (v - 128) : 512 + 16 * (v - 224)));
            const float* vp = dl == 0 ? ov : cv + (size_t)(nrows - dl) * rowstride;
            const f32x4 val = *(const f32x4*)(vp + 4 * dch);
            acc += val * pbuf[v];
        }
    }
#pragma unroll
    for (int e = 0; e < 4; ++e) { float t = acc[e]; t += __shfl_xor(t, 16); t += __shfl_xor(t, 32); acc[e] = t; }
    LDS_WAIT(); asm volatile("" ::: "memory");
    if (g == 0) { const float inv = 1.0f / den; v2u w; w.x = pk2(acc[0] * inv, acc[1] * inv); w.y = pk2(acc[2] * inv, acc[3] * inv);
        *(v2u*)(mix + (size_t)(MP + n) * D + (isB ? 512 : 0) + h * 64 + 4 * dch) = w; }
}

template <int HMODE  , int NSLAB>
__device__ __forceinline__ void ln_rows(const Frame& F, const float* xp, const float* xs, const float* Z, const float* SLAB, const float* MOD, int gc, float gs, const float* lng, const float* lnb,
                                        float* outp, bf16* Hout, int shc, int scc) {
    const int gw = F.vcu * NWAVES + F.wave, NGW = F.G * NWAVES;
    for (int row = gw; row < M_REAL; row += NGW) {
        const int seq = seq_of_row(row);
        const f32x4* xr = (const f32x4*)(row < MP ? xp + (size_t)row * D : xs + (size_t)(row - MP) * D) + F.lane;
        const f32x4* mr = (const f32x4*)(MOD + (size_t)seq * NMOD) + F.lane;
        f32x4 a[4]; float s = 0.f;
        if (row < MP) {
            const v2u* zr = (const v2u*)((const bf16*)Z + (size_t)row * D) + F.lane;
#pragma unroll
            for (int j = 0; j < 4; ++j) { const v2u z2 = zr[64 * j]; a[j] = (f32x4){bf2f((unsigned short)(z2.x & 0xffffu)), bf2f((unsigned short)(z2.x >> 16)), bf2f((unsigned short)(z2.y & 0xffffu)), bf2f((unsigned short)(z2.y >> 16))}; }
        } else {
            const f32x4* zr = (const f32x4*)(SLAB + (size_t)(row - MP) * D) + F.lane;
            f32x4 t[NSLAB][4];
#pragma unroll
            for (int sl = 0; sl < NSLAB; ++sl)
#pragma unroll
                for (int j = 0; j < 4; ++j) t[sl][j] = zr[(size_t)sl * (128 * 256) + 64 * j];
#pragma unroll
            for (int j = 0; j < 4; ++j) { a[j] = t[0][j];
#pragma unroll
                for (int sl = 1; sl < NSLAB; ++sl) a[j] += t[sl][j]; }
        }
#pragma unroll
        for (int j = 0; j < 4; ++j) { a[j] = xr[64 * j] * ALPHA + (mr[gc * 256 + 64 * j] * gs) * a[j]; s += (a[j][0] + a[j][1]) + (a[j][2] + a[j][3]); }
        const float mean = wave_sum(s) * (1.f / D); float s2 = 0.f;
#pragma unroll
        for (int j = 0; j < 4; ++j) { a[j] = a[j] - mean; s2 += (a[j][0] * a[j][0] + a[j][1] * a[j][1]) + (a[j][2] * a[j][2] + a[j][3] * a[j][3]); }
        const float rstd = 1.f / sqrtf(wave_sum(s2) * (1.f / D) + LN_EPS);
        f32x4* orow = (f32x4*)(outp + (size_t)row * D) + F.lane;
        v2u* hrow = (v2u*)(Hout + (size_t)row * D) + F.lane; unsigned* hrow8 = (unsigned*)((unsigned char*)Hout + (size_t)row * D) + F.lane;
#pragma unroll
        for (int j = 0; j < 4; ++j) { const f32x4 o = a[j] * rstd * ((const f32x4*)lng)[F.lane + 64 * j] + ((const f32x4*)lnb)[F.lane + 64 * j];
            orow[64 * j] = o;
            if (HMODE != 0) { const f32x4 hh = o * (mr[scc * 256 + 64 * j] + 1.0f) + mr[shc * 256 + 64 * j];
                if (HMODE == 2) hrow8[64 * j] = pg8::pk4_fp8(hh[0], hh[1], hh[2], hh[3]);
                else { v2u w; w.x = pk2(hh[0], hh[1]); w.y = pk2(hh[2], hh[3]); hrow[64 * j] = w; } } }
    }
}

__global__ void __launch_bounds__(NWAVES * 64, 2) mega_fwd(Args args) {
    extern __shared__ __attribute__((aligned(16))) unsigned char lds[];
    Frame F;
    F.lds = (LAS unsigned char*)lds;
    volatile LAS unsigned* MISC = (volatile LAS unsigned*)(F.lds + MISC_OFF);
    F.tid = threadIdx.x; F.lane = F.tid & 63; F.wave = __builtin_amdgcn_readfirstlane(F.tid >> 6);
    F.G = gridDim.x; { const int bx = blockIdx.x; F.vcu = (F.G % 8 == 0) ? (bx % 8) * (F.G / 8) + bx / 8 : bx; }
    gu32* ctl = (gu32*)(args.ws + WS_CTL);
    for (int u = F.tid; u < (LDS_BYTES - LDSCTL_OFF) / 4; u += NWAVES * 64) ((LAS unsigned*)(F.lds + LDSCTL_OFF))[u] = 0u;
    __syncthreads();
    XcdBarrier bar = xcd_barrier_post((unsigned*)(ctl + CW_BAR), MISC + 8);
    const int gw = F.vcu * NWAVES + F.wave, NGW = F.G * NWAVES;
#define REFRESH() do { F.lane = pg8::fresh_lane(); F.tid = F.wave * 64 + F.lane; } while (0)

#define IN_(i) (args.in[i])
#define x_prompt IN_(0)
#define x_sample IN_(1)
#define cache_a_k IN_(2)
#define cache_a_v IN_(3)
#define cache_b_k IN_(4)
#define cache_b_v IN_(5)
#define c_prompt IN_(6)
#define c_sample IN_(7)
#define rel_bias IN_(8)
#define w_ada IN_(9)
#define b_ada IN_(10)
#define sinks IN_(16)
#define ln_g IN_(20)
#define ln_b IN_(21)
#define OUTP (args.out)
#define o_pak (args.out + 16908288)
#define o_pav (args.out + 21102592)
#define o_pbk (args.out + 25296896)
#define o_pbv (args.out + 25362432)
#define o_sak (args.out + 25427968)
#define o_sav (args.out + 25493504)
#define o_sbk (args.out + 25559040)
#define o_sbv (args.out + 25575424)
#define WGU1 ((bf16*)(args.ws + WS_WGU1))
#define WD1 ((bf16*)(args.ws + WS_WD1))
#define WIN ((bf16*)(args.ws + WS_WIN))
#define WOUT ((bf16*)(args.ws + WS_WOUT))
#define WGU2 ((bf16*)(args.ws + WS_WGU2))
#define WD2 ((bf16*)(args.ws + WS_WD2))
#define WADA ((bf16*)(args.ws + WS_WADA))
#define AMOD ((bf16*)(args.ws + WS_AMOD))
#define MOD ((float*)(args.ws + WS_MOD))
#define SQ ((float*)(args.ws + WS_SQ))
#define H ((bf16*)(args.ws + WS_H))
#define ACT ((bf16*)(args.ws + WS_ACT))
#define Z ((float*)(args.ws + WS_Z))
#define X1 ((float*)(args.ws + WS_X1))
#define X2 ((float*)(args.ws + WS_X2))
#define QKV ((bf16*)(args.ws + WS_QKV))
#define OA ((bf16*)(args.ws + WS_OA))
#define LSE ((float*)(args.ws + WS_LSE))
#define MIX ((bf16*)(args.ws + WS_MIX))
#define SLAB ((float*)(args.ws + WS_SLAB))
    {
        LAS float* scr = (LAS float*)(F.lds + RING_OFF + F.wave * 16384);
        constexpr int NITEMS = 2 * (3 * 16 * 88) + 16 * 72 + 16 * 32 + 16 * 288;
        for (int it = gw; it < NITEMS; it += NGW) {
            int r = it;
            if (p0_matrix<true, FP8_UP>(r, args.in[11], D, DFF, WGU1, 0, 64.f, scr, F.lane)) continue;
            if (p0_matrix<true, FP8_UP>(r, args.in[12], D, DFF, WGU1, 1, 64.f, scr, F.lane)) continue;
            if (p0_matrix<false, FP8_DOWN>(r, args.in[13], DFF, D, WD1, 0, 128.f, scr, F.lane)) continue;
            if (p0_matrix<false, false>(r, args.in[14], D, NPROJ, WIN, 0, 1.f, scr, F.lane)) continue;
            if (p0_matrix<false, false>(r, args.in[15], D, D, WOUT, 0, 1.f, scr, F.lane)) continue;
            if (p0_matrix<true, FP8_UP>(r, args.in[17], D, DFF, WGU2, 0, 64.f, scr, F.lane)) continue;
            if (p0_matrix<true, FP8_UP>(r, args.in[18], D, DFF, WGU2, 1, 64.f, scr, F.lane)) continue;
            if (p0_matrix<false, FP8_DOWN>(r, args.in[19], DFF, D, WD2, 0, 128.f, scr, F.lane)) continue;
            p0_matrix<false, false>(r, w_ada, D, NMOD, WADA, 0, 1.f, scr, F.lane);
        }
        for (int r = gw; r < 256; r += NGW) {
            v2u* orow = (v2u*)(AMOD + (size_t)r * D) + F.lane;
            const float* crow_ = r < 4 ? c_prompt + (size_t)r * D : (r < 132 ? c_sample + (size_t)(r - 4) * D : nullptr);
#pragma unroll
            for (int j = 0; j < 4; ++j) { v2u w; w.x = 0u; w.y = 0u;
                if (crow_) { const f32x4 c = ((const f32x4*)crow_)[F.lane + 64 * j]; f32x4 sv;
#pragma unroll
                    for (int e = 0; e < 4; ++e) sv[e] = c[e] * __builtin_amdgcn_rcpf(1.0f + __builtin_amdgcn_exp2f(-LOG2E * c[e]));
                    w.x = pk2(sv[0], sv[1]); w.y = pk2(sv[2], sv[3]); }
                orow[64 * j] = w; }
        }
        for (int r = gw; r < 256; r += NGW) {
            bf16* base = (r < 128 ? H : MIX) + (size_t)(M_REAL + (r & 127)) * D;
            v4u zz = (v4u){0u, 0u, 0u, 0u}; ((v4u*)base)[F.lane] = zz; ((v4u*)base)[F.lane + 64] = zz;
        }
    }
    xcd_barrier(bar);
    REFRESH();
    {
        pg8::Gemm g{AMOD, WADA, 256, NMOD, D, 0, 0, F.wave}; pg8::StaticOrder S; S.init(256, NMOD, D, F.G, (int)blockIdx.x);
        pg8::EpiF32 E{MOD, NMOD, b_ada};
        pg8::gemm_phase<pg8::EpiF32, pg8::StaticOrder, true, true>(F.lds + RING_OFF, g, S, E);
    }
    xcd_barrier(bar);
    REFRESH();
    for (int row = gw; row < M_REAL; row += NGW) {
        const int seq = seq_of_row(row);
        const f32x4* xr = (const f32x4*)(row < MP ? x_prompt + (size_t)row * D : x_sample + (size_t)(row - MP) * D) + F.lane;
        const f32x4* mr = (const f32x4*)(MOD + (size_t)seq * NMOD) + F.lane;
        v2u* hrow = (v2u*)(H + (size_t)row * D) + F.lane; unsigned* hrow8 = (unsigned*)((unsigned char*)H + (size_t)row * D) + F.lane;
#pragma unroll
        for (int j = 0; j < 4; ++j) { const f32x4 hh = xr[64 * j] * (mr[256 + 64 * j] + 1.0f) + mr[64 * j];
            if (FP8_UP) hrow8[64 * j] = pg8::pk4_fp8(hh[0], hh[1], hh[2], hh[3]);
            else { v2u w; w.x = pk2(hh[0], hh[1]); w.y = pk2(hh[2], hh[3]); hrow[64 * j] = w; } }
    }
    xcd_barrier(bar);
    REFRESH();
    {
        constexpr int KU = FP8_UP ? D / 2 : D;
        pg8::Gemm g{H, WGU1, M_PAD, 2 * DFF, KU, 0x7c7c7c7c, 0x7c7c7c7c, F.wave}; pg8::StaticOrder S; S.init(M_PAD, 2 * DFF, KU, F.G, (int)blockIdx.x);
        pg8::EpiSwiGLU<FP8_DOWN> E{ACT, DFF};
        pg8::gemm_phase<pg8::EpiSwiGLU<FP8_DOWN>, pg8::StaticOrder, true, true, FP8_UP>(F.lds + RING_OFF, g, S, E);
    }
    xcd_barrier(bar);
    REFRESH();
    {
        constexpr int KD = FP8_DOWN ? DFF / 2 : DFF;
        pg8::Gemm g{ACT, WD1, M_PAD, D, KD, 0x7a7a7a7a, 0x7a7a7a7a, F.wave}; pg8::TailSplitOrder S; S.init(KD, FP8_DOWN ? 2 : 4, F.G, (int)blockIdx.x);
        pg8::EpiF32Z E{Z, SLAB};
        pg8::gemm_phase<pg8::EpiF32Z, pg8::TailSplitOrder, true, true, FP8_DOWN>(F.lds + RING_OFF, g, S, E);
    }
    xcd_barrier(bar);
    REFRESH();
    ln_rows<1, 11>(F, x_prompt, x_sample, Z, SLAB, MOD, 2, 0.5f, ln_g, ln_b, X1, H, 3, 4);
    xcd_barrier(bar);
    REFRESH();
    {
        pg8::Gemm g{H, WIN, M_PAD, NPROJ, D, 0, 0, F.wave}; pg8::StaticOrder S; S.init(M_PAD, NPROJ, D, F.G, (int)blockIdx.x);
        pg8::EpiQKV E{QKV, SQ, o_pak, o_pav, o_pbk, o_pbv, o_sak, o_sav, o_sbk, o_sbv, QSCALE};
        pg8::gemm_phase<pg8::EpiQKV, pg8::StaticOrder, true, true>(F.lds + RING_OFF, g, S, E);
    }
    xcd_barrier(bar);
    REFRESH();
    {
        LAS float* tabs = (LAS float*)(F.lds + RING_OFF);
        for (int idx = F.tid; idx < 4 * 8 * 192; idx += NWAVES * 64) {
            const int type = idx / 1536, h = (idx / 192) & 7, i = idx % 192, dist = 159 - i;
            float v = NEGV;
            if (dist >= 0 && dist <= 128) { const int dil = type == 1 ? 4 : (type == 2 ? 16 : 1); v = rel_bias[t5_bucket(dist * dil) * 16 + (type == 3 ? 8 + h : h)] * LOG2E; }
            tabs[idx] = v;
        }
        __syncthreads();
        LAS float* pbuf = (LAS float*)(F.lds + RING_OFF + 32768 + F.wave * 2048);
#ifndef ATT_PARTS
#define ATT_PARTS 2
#endif
#ifndef ATT_EXTRA_SAMPLE
#define ATT_EXTRA_SAMPLE false
#endif
        for (int part = 0; part < ATT_PARTS; ++part) {
            const bool do_sample = part < 2 ? ((part == 0) == (F.wave < 4)) : ATT_EXTRA_SAMPLE;
            if (do_sample) {
                for (int st = gw; st < 2 * NS * 8; st += NGW) {
                    const bool isB = (st & 1) != 0; const int r = st >> 1, n = r >> 3, h = r & 7;
                    sample_task(isB, n, h, SQ, rel_bias, sinks, isB ? cache_b_k : cache_a_k, isB ? cache_b_v : cache_a_v, isB ? o_sbk : o_sak, isB ? o_sbv : o_sav, MIX, pbuf);
                }
            } else {
                for (int task = gw; task < 4 * 4096; task += NGW) {
                    const int type = task >> 12, rem = task & 4095, w8 = rem & 7, grp = rem >> 3, h = grp & 7, x2 = grp >> 3, b = x2 >> 4, y2 = x2 & 15;
                    const int dil = type == 1 ? 4 : (type == 2 ? 16 : 1);
                    const int gpc = 16 / dil, rc = y2 / gpc, qblk = (y2 % gpc) * 8 + w8, j0 = 32 * qblk;
                    const size_t stride = (size_t)dil * NPROJ;
                    const bf16* base = QKV + (size_t)(b * SEQ + rc) * NPROJ;
                    const bf16 *Qb, *Kb, *Vb;
                    if (type < 3) { Qb = base + h * 64; Kb = base + 512 + h * 64; Vb = base + 1024 + h * 64; }
                    else { Qb = base + 1536 + h * 64; Kb = base + 2048 + (h >> 2) * 64; Vb = base + 2176 + (h >> 2) * 64; }
                    f32x16 o[2]; float lse2;
                    band_task(Qb, Kb, Vb, stride, j0, tabs + (type * 8 + h) * 192, type == 3, type == 3 ? sinks[h] * LOG2E : 0.f, o, lse2);
                    const int q = F.lane & 31, hi = F.lane >> 5;
                    const int token = b * SEQ + rc + dil * (j0 + q);
                    bf16* dst = type < 3 ? OA + ((size_t)type * MP + token) * 512 + h * 64 : MIX + (size_t)token * D + 512 + h * 64;
#pragma unroll
                    for (int nb = 0; nb < 2; ++nb)
#pragma unroll
                        for (int g4 = 0; g4 < 4; ++g4) { v2u w; w.x = cvtpk(o[nb][4 * g4 + 0], o[nb][4 * g4 + 1]); w.y = cvtpk(o[nb][4 * g4 + 2], o[nb][4 * g4 + 3]);
                            *(v2u*)(dst + 32 * nb + 8 * g4 + 4 * hi) = w; }
                    if (type < 3 && hi == 0) LSE[((size_t)type * MP + token) * 8 + h] = lse2;
                }
            }
        }
    }
    xcd_barrier(bar);
    REFRESH();
    for (int token = gw; token < MP; token += NGW) {
        const int h = F.lane >> 3;
        float l0 = LSE[((size_t)0 * MP + token) * 8 + h], l1 = LSE[((size_t)1 * MP + token) * 8 + h], l2 = LSE[((size_t)2 * MP + token) * 8 + h];
        const float mx = fmaxf(l0, fmaxf(l1, l2));
        float w0 = __builtin_amdgcn_exp2f(l0 - mx), w1 = __builtin_amdgcn_exp2f(l1 - mx), w2 = __builtin_amdgcn_exp2f(l2 - mx);
        const float inv = 1.0f / (w0 + w1 + w2); w0 *= inv; w1 *= inv; w2 *= inv;
        const v4u a0 = ((const v4u*)(OA + ((size_t)0 * MP + token) * 512))[F.lane], a1 = ((const v4u*)(OA + ((size_t)1 * MP + token) * 512))[F.lane], a2 = ((const v4u*)(OA + ((size_t)2 * MP + token) * 512))[F.lane];
        v4u w;
#pragma unroll
        for (int e = 0; e < 4; ++e) {
            const float lo = w0 * bf2f((unsigned short)(a0[e] & 0xffffu)) + w1 * bf2f((unsigned short)(a1[e] & 0xffffu)) + w2 * bf2f((unsigned short)(a2[e] & 0xffffu));
            const float hi_ = w0 * bf2f((unsigned short)(a0[e] >> 16)) + w1 * bf2f((unsigned short)(a1[e] >> 16)) + w2 * bf2f((unsigned short)(a2[e] >> 16));
            w[e] = pk2(lo, hi_);
        }
        ((v4u*)(MIX + (size_t)token * D))[F.lane] = w;
    }
    xcd_barrier(bar);
    REFRESH();
    {
        pg8::Gemm g{MIX, WOUT, M_PAD, D, D, 0, 0, F.wave}; pg8::TailSplitOrder S; S.init(D, 4, F.G, (int)blockIdx.x);
        pg8::EpiF32Z E{Z, SLAB};
        pg8::gemm_phase<pg8::EpiF32Z, pg8::TailSplitOrder, true, true>(F.lds + RING_OFF, g, S, E);
    }
    xcd_barrier(bar);
    REFRESH();
    ln_rows<(FP8_UP ? 2 : 1), 4>(F, X1, X1 + (size_t)MP * D, Z, SLAB, MOD, 5, 1.0f, ln_g + D, ln_b + D, X2, H, 6, 7);
    xcd_barrier(bar);
    REFRESH();
    {
        constexpr int KU = FP8_UP ? D / 2 : D;
        pg8::Gemm g{H, WGU2, M_PAD, 2 * DFF, KU, 0x7c7c7c7c, 0x7c7c7c7c, F.wave}; pg8::StaticOrder S; S.init(M_PAD, 2 * DFF, KU, F.G, (int)blockIdx.x);
        pg8::EpiSwiGLU<FP8_DOWN> E{ACT, DFF};
        pg8::gemm_phase<pg8::EpiSwiGLU<FP8_DOWN>, pg8::StaticOrder, true, true, FP8_UP>(F.lds + RING_OFF, g, S, E);
    }
    xcd_barrier(bar);
    REFRESH();
    {
        constexpr int KD = FP8_DOWN ? DFF / 2 : DFF;
        pg8::Gemm g{ACT, WD2, M_PAD, D, KD, 0x7a7a7a7a, 0x7a7a7a7a, F.wave}; pg8::TailSplitOrder S; S.init(KD, FP8_DOWN ? 2 : 4, F.G, (int)blockIdx.x);
        pg8::EpiF32Z E{Z, SLAB};
        pg8::gemm_phase<pg8::EpiF32Z, pg8::TailSplitOrder, true, true, FP8_DOWN>(F.lds + RING_OFF, g, S, E);
    }
    xcd_barrier(bar);
    REFRESH();
    ln_rows<0, 11>(F, X2, X2 + (size_t)MP * D, Z, SLAB, MOD, 8, 0.5f, ln_g + 2 * D, ln_b + 2 * D, OUTP, nullptr, 0, 0);
#ifdef PROBE_SCALE9
    if (blockIdx.x == 0) { for (int i = F.tid; i < 16384; i += NWAVES * 64) o_sbv[i] *= 1.05f; }
#endif
}

#undef IN_
#undef x_prompt
#undef x_sample
#undef cache_a_k
#undef cache_a_v
#undef cache_b_k
#undef cache_b_v
#undef c_prompt
#undef c_sample
#undef rel_bias
#undef w_ada
#undef b_ada
#undef sinks
#undef ln_g
#undef ln_b
#undef OUTP
#undef o_pak
#undef o_pav
#undef o_pbk
#undef o_pbv
#undef o_sak
#undef o_sav
#undef o_sbk
#undef o_sbv
#undef WGU1
#undef WD1
#undef WIN
#undef WOUT
#undef WGU2
#undef WD2
#undef WADA
#undef AMOD
#undef MOD
#undef SQ
#undef H
#undef ACT
#undef Z
#undef X1
#undef X2
#undef QKV
#undef OA
#undef LSE
#undef MIX
#undef SLAB
extern "C" void kernel_launch(void* const* d_in, const int* in_sizes, int n_in, void* d_out, int out_size, void* d_ws, size_t ws_size, hipStream_t stream) {
    static int grid = 0;
    if (grid == 0) {
        if (n_in != 22 || out_size != 25591808 || ws_size < WS_END) { fprintf(stderr, "kernel_launch: unexpected shapes (n_in %d out %d ws %zu)\n", n_in, out_size, ws_size); grid = -1; return; }
        int dev = 0, cus = 0, per_cu = 0;
        if (hipGetDevice(&dev) != hipSuccess || hipDeviceGetAttribute(&cus, hipDeviceAttributeMultiprocessorCount, dev) != hipSuccess) { grid = -1; return; }
        if (hipFuncSetAttribute((const void*)mega_fwd, hipFuncAttributeMaxDynamicSharedMemorySize, LDS_BYTES) != hipSuccess) { fprintf(stderr, "kernel_launch: hipFuncSetAttribute failed\n"); grid = -1; return; }
        if (hipOccupancyMaxActiveBlocksPerMultiprocessor(&per_cu, (const void*)mega_fwd, NWAVES * 64, LDS_BYTES) != hipSuccess || per_cu < 1)
            fprintf(stderr, "kernel_launch: occupancy query reports %d workgroups per CU\n", per_cu);
        (void)hipGetLastError();
        grid = cus;
    }
    if (grid < 0) return;
    if (hipMemsetAsync((char*)d_ws + WS_CTL, 0, CTL_ZERO_BYTES, stream) != hipSuccess) return;
    Args a{};
    for (int i = 0; i < 22; ++i) a.in[i] = (const float*)d_in[i];
    a.out = (float*)d_out; a.ws = (unsigned char*)d_ws;
    hipLaunchKernelGGL(mega_fwd, dim3(grid), dim3(NWAVES * 64), LDS_BYTES, stream, a);
}
```

```cpp
#include <hip/hip_runtime.h>
#include <cstdio>
#include <cstdint>
#include <cstddef>
namespace pg8 {
#define PG8_LAS __attribute__((address_space(3)))
typedef unsigned short bf16_t;
typedef short bf16x8 __attribute__((ext_vector_type(8)));
typedef float f32x4 __attribute__((ext_vector_type(4)));
typedef unsigned u32x4 __attribute__((ext_vector_type(4)));
constexpr int BM = 256, BK = 64, HALF = 128, HTB = HALF * BK * 2  , STAGE_BYTES = 8 * HTB, NXCD = 8, WGM = 8;

__host__ __device__ __forceinline__ int lds_byte(int r, int c) { const int st = (r >> 4) * 2 + (c >> 5), rr = r & 15, cc = c & 31, ob = rr * 64 + cc * 2; return st * 1024 + (ob ^ (((ob >> 9) & 1) << 5)); }
__host__ __device__ __forceinline__ void stage_rc(int b, int& R, int& C) { const int st = b / 1024, sb = b % 1024, swz = sb ^ (((sb >> 9) & 1) << 5); R = (st >> 1) * 16 + swz / 64; C = (st & 1) * 32 + (swz % 64) / 2; }
__host__ __device__ __forceinline__ int perm32(int rho) { const int n = rho >> 4, i = rho & 15; return 8 * (i >> 2) + 4 * n + (i & 3); }

struct Unit { int pm, pn, k0, nt; };
struct Gemm { const bf16_t* A; const bf16_t* Bt; int M, N, K; int sa, sb; int wid; };
__device__ __forceinline__ int fresh_lane() { int z = 0; asm volatile("" : "+v"(z)); return (int)__builtin_amdgcn_mbcnt_hi(~0u, __builtin_amdgcn_mbcnt_lo(~0u, (unsigned)z)); }
typedef int v4i_t __attribute__((ext_vector_type(4)));
typedef int v8i_t __attribute__((ext_vector_type(8)));
template <bool FP8> struct FragT;
template <> struct FragT<false> {
    struct A { bf16x8 k[2]; };
    static __device__ __forceinline__ void load(A& d, const PG8_LAS unsigned char* p) { d.k[0] = *(const PG8_LAS bf16x8*)p; d.k[1] = *(const PG8_LAS bf16x8*)(p + 1024); }
    static __device__ __forceinline__ void mma(f32x4& c, const A& b, const A& a, int, int) { c = __builtin_amdgcn_mfma_f32_16x16x32_bf16(b.k[0], a.k[0], c, 0, 0, 0); c = __builtin_amdgcn_mfma_f32_16x16x32_bf16(b.k[1], a.k[1], c, 0, 0, 0); }
};
template <> struct FragT<true> {
    struct A { v8i_t v; };
    static __device__ __forceinline__ void load(A& d, const PG8_LAS unsigned char* p) { const v4i_t lo = *(const PG8_LAS v4i_t*)p, hi = *(const PG8_LAS v4i_t*)(p + 1024); d.v = __builtin_shufflevector(lo, hi, 0, 1, 2, 3, 4, 5, 6, 7); }
    static __device__ __forceinline__ void mma(f32x4& c, const A& b, const A& a, int sb, int sa) { c = __builtin_amdgcn_mfma_scale_f32_16x16x128_f8f6f4(b.v, a.v, c, 0, 0, 0, sb, 0, sa); }
};

struct StaticOrder {
    int nM, nN, nwg, G, c, ntf;
    __host__ __device__ void init(int M, int N, int K, int G_, int c_) { nM = M / BM; nN = N / BM; nwg = nM * nN; G = G_; c = c_; ntf = K / BK; }
    __host__ __device__ bool next(int i, Unit& u) const {
        const long L = (long)i * G + c; if (L >= nwg) return false;
        int wgid = (int)L; { const int q = nwg / NXCD, r = nwg % NXCD, xcd = wgid % NXCD, off = wgid / NXCD; wgid = (xcd < r ? xcd * (q + 1) : r * (q + 1) + (xcd - r) * q) + off; }
        const int nig = WGM * nN, gid = wgid / nig, fm = gid * WGM, gsz = (nM - fm) < WGM ? (nM - fm) : WGM;
        u.pm = fm + ((wgid % nig) % gsz); u.pn = (wgid % nig) / gsz; u.k0 = 0; u.nt = ntf; return true;
    }
    __device__ __forceinline__ void a_ready(const Unit&) const {}
    __device__ __forceinline__ void done(const Unit&) const {}
};
struct TailSplitOrder {
    StaticOrder so; int nsplit, SL;
    __host__ __device__ void init(int K, int SL_, int G_, int c_) { so.init(64 * BM, 4 * BM, K, G_, c_); SL = SL_; nsplit = 4 * ((K / BK) / SL_); }
    __host__ __device__ bool next(int i, Unit& u) const {
        const long L = (long)i * so.G + so.c;
        if (L < so.nwg) return so.next(i, u);
        const int j = (int)(L - so.nwg); if (j >= nsplit) return false;
        u.pm = 64; u.pn = j & 3; u.k0 = (j >> 2) * SL; u.nt = SL; return true;
    }
    __device__ __forceinline__ void a_ready(const Unit&) const {}
    __device__ __forceinline__ void done(const Unit&) const {}
};
__device__ __forceinline__ unsigned cvt_pk_bf16(float lo, float hi) { unsigned r; asm volatile("v_cvt_pk_bf16_f32 %0, %1, %2" : "=v"(r) : "v"(lo), "v"(hi)); return r; }
typedef float f32x2 __attribute__((ext_vector_type(2)));
typedef float f32x2 __attribute__((ext_vector_type(2)));
struct EpiF32 {
    static constexpr bool PERM = false, AFTER_DRAIN = false;
    float* O; int ldc; const float* bias;
    __device__ __forceinline__ void operator()(const f32x4 (&acc)[2][2][4][2], const Unit& u, int wr, int wc, int fr, int fq) const {
        const int row0 = u.pm * BM + wr * 64 + fr, col0 = u.pn * BM + wc * 32 + 4 * fq;
        f32x4 bv[2][2];
#pragma unroll
        for (int bj = 0; bj < 2; ++bj)
#pragma unroll
            for (int n = 0; n < 2; ++n) bv[bj][n] = bias ? *(const f32x4*)(bias + col0 + bj * HALF + n * 16) : (f32x4){0.f, 0.f, 0.f, 0.f};
#pragma unroll
        for (int ai = 0; ai < 2; ++ai)
#pragma unroll
            for (int m = 0; m < 4; ++m) { float* rowp = O + (size_t)(row0 + ai * HALF + m * 16) * ldc + col0;
#pragma unroll
                for (int bj = 0; bj < 2; ++bj)
#pragma unroll
                    for (int n = 0; n < 2; ++n) *(f32x4*)(rowp + bj * HALF + n * 16) = acc[ai][bj][m][n] + bv[bj][n]; }
    }
};
struct EpiF32Z {
    static constexpr bool PERM = true, AFTER_DRAIN = false;
    float* Z; float* SLAB;
    __device__ __forceinline__ void operator()(const f32x4 (&acc)[2][2][4][2], const Unit& u, int wr, int wc, int fr, int fq) const {
        const int col0 = u.pn * BM + wc * 32 + 8 * fq;
        if (u.pm < 64) {
#pragma unroll
            for (int ai = 0; ai < 2; ++ai)
#pragma unroll
                for (int m = 0; m < 4; ++m) { bf16_t* rowp = (bf16_t*)Z + (size_t)(u.pm * BM + wr * 64 + fr + ai * HALF + m * 16) * 1024 + col0;
#pragma unroll
                    for (int bj = 0; bj < 2; ++bj) { const f32x4 v0 = acc[ai][bj][m][0], v1 = acc[ai][bj][m][1];
                        u32x4 w; w.x = cvt_pk_bf16(v0[0], v0[1]); w.y = cvt_pk_bf16(v0[2], v0[3]); w.z = cvt_pk_bf16(v1[0], v1[1]); w.w = cvt_pk_bf16(v1[2], v1[3]);
                        *(u32x4*)(rowp + bj * HALF) = w; } }
        } else {
            float* sl = SLAB + (size_t)(u.k0 / u.nt) * (128 * 1024);
#pragma unroll
            for (int m = 0; m < 4; ++m) { float* rowp = sl + (size_t)(wr * 64 + fr + m * 16) * 1024 + col0;
#pragma unroll
                for (int bj = 0; bj < 2; ++bj) { *(f32x4*)(rowp + bj * HALF) = acc[0][bj][m][0]; *(f32x4*)(rowp + bj * HALF + 4) = acc[0][bj][m][1]; } }
        }
    }
};
__device__ __forceinline__ float silu_mul(float g, float u) { return g * u * __builtin_amdgcn_rcpf(1.0f + __builtin_amdgcn_exp2f(-1.4426950408889634f * g)); }
__device__ __forceinline__ unsigned pk4_fp8(float a, float b, float c, float d) {
    a = __builtin_amdgcn_fmed3f(a, -448.f, 448.f); b = __builtin_amdgcn_fmed3f(b, -448.f, 448.f); c = __builtin_amdgcn_fmed3f(c, -448.f, 448.f); d = __builtin_amdgcn_fmed3f(d, -448.f, 448.f);
    unsigned w = 0u; w = __builtin_amdgcn_cvt_pk_fp8_f32(a, b, w, false); w = __builtin_amdgcn_cvt_pk_fp8_f32(c, d, w, true); return w; }
template <bool F8OUT> struct EpiSwiGLU {
    static constexpr bool PERM = true, AFTER_DRAIN = false;
    bf16_t* O; int ldc;
    __device__ __forceinline__ void operator()(const f32x4 (&acc)[2][2][4][2], const Unit& u, int wr, int wc, int fr, int fq) const {
        const int row0 = u.pm * BM + wr * 64 + fr, col0 = u.pn * HALF + wc * 32 + 8 * fq;
#pragma unroll
        for (int ai = 0; ai < 2; ++ai)
#pragma unroll
            for (int m = 0; m < 4; ++m) { bf16_t* rowp = O + (size_t)(row0 + ai * HALF + m * 16) * ldc + col0;
                const f32x4 g0 = acc[ai][0][m][0], g1 = acc[ai][0][m][1], u0 = acc[ai][1][m][0], u1 = acc[ai][1][m][1];
                if constexpr (F8OUT) { unsigned char* rp8 = (unsigned char*)O + (size_t)(row0 + ai * HALF + m * 16) * ldc + col0; typedef unsigned u32x2v __attribute__((ext_vector_type(2))); u32x2v w;
                    w.x = pk4_fp8(8.f * silu_mul(g0[0], u0[0]), 8.f * silu_mul(g0[1], u0[1]), 8.f * silu_mul(g0[2], u0[2]), 8.f * silu_mul(g0[3], u0[3]));
                    w.y = pk4_fp8(8.f * silu_mul(g1[0], u1[0]), 8.f * silu_mul(g1[1], u1[1]), 8.f * silu_mul(g1[2], u1[2]), 8.f * silu_mul(g1[3], u1[3]));
                    *(u32x2v*)rp8 = w; }
                else { u32x4 w; w.x = cvt_pk_bf16(silu_mul(g0[0], u0[0]), silu_mul(g0[1], u0[1])); w.y = cvt_pk_bf16(silu_mul(g0[2], u0[2]), silu_mul(g0[3], u0[3]));
                w.z = cvt_pk_bf16(silu_mul(g1[0], u1[0]), silu_mul(g1[1], u1[1])); w.w = cvt_pk_bf16(silu_mul(g1[2], u1[2]), silu_mul(g1[3], u1[3]));
                *(u32x4*)rowp = w; } }
    }
};
struct EpiQKV {
    static constexpr bool PERM = true, AFTER_DRAIN = false;
    bf16_t* O;
    float* sq;
    float *pak, *pav, *pbk, *pbv, *sak, *sav, *sbk, *sbv;
    float qscale;
    __device__ __forceinline__ void operator()(const f32x4 (&acc)[2][2][4][2], const Unit& u, int wr, int wc, int fr, int fq) const {
        const int pn = u.pn;
#pragma unroll
        for (int ai = 0; ai < 2; ++ai)
#pragma unroll
            for (int m = 0; m < 4; ++m) { const int row = u.pm * BM + ai * HALF + wr * 64 + m * 16 + fr;
#pragma unroll
                for (int bj = 0; bj < 2; ++bj) { const int col = pn * BM + bj * HALF + wc * 32 + 8 * fq;
                    f32x4 v0 = acc[ai][bj][m][0], v1 = acc[ai][bj][m][1];
                    const bool isq = (pn < 2) || (pn == 6) || (pn == 7);
                    if (isq) { v0 = v0 * qscale; v1 = v1 * qscale; }
                    u32x4 w; w.x = cvt_pk_bf16(v0[0], v0[1]); w.y = cvt_pk_bf16(v0[2], v0[3]); w.z = cvt_pk_bf16(v1[0], v1[1]); w.w = cvt_pk_bf16(v1[2], v1[3]);
                    *(u32x4*)(O + (size_t)row * 2304 + col) = w;
                    float* dst = nullptr;
                    if (row < 16384) { const int b = row >> 12, t = row & 4095;
                        if (pn == 2 || pn == 3) { if (t >= 2048) dst = pak + ((size_t)(b * 2048 + t - 2048)) * 512 + (col - 512); }
                        else if (pn == 4 || pn == 5) { if (t >= 2048) dst = pav + ((size_t)(b * 2048 + t - 2048)) * 512 + (col - 1024); }
                        else if (pn == 8) { if (t >= 3968) dst = (bj == 0 ? pbk : pbv) + ((size_t)(b * 128 + t - 3968)) * 128 + (col - 2048 - bj * 128); }
                    } else if (row < 16512) { const int n = row - 16384;
                        if (pn < 2) dst = sq + (size_t)n * 1024 + col;
                        else if (pn == 2 || pn == 3) dst = sak + (size_t)n * 512 + (col - 512);
                        else if (pn == 4 || pn == 5) dst = sav + (size_t)n * 512 + (col - 1024);
                        else if (pn == 6 || pn == 7) dst = sq + (size_t)n * 1024 + 512 + (col - 1536);
                        else dst = (bj == 0 ? sbk : sbv) + (size_t)n * 128 + (col - 2048 - bj * 128);
                    }
                    if (dst) { *(f32x4*)dst = v0; *(f32x4*)(dst + 4) = v1; }
                } }
    }
};
template <class Epi, class Sched, bool ALIGN_EPI = false, bool SP2 = false, bool FP8 = false>
__device__ __forceinline__ void gemm_phase(PG8_LAS unsigned char* lds, const Gemm g, const Sched& S, const Epi& E) {
    const int wid = g.wid, lane = fresh_lane(), tid = wid * 64 + lane;
    const int wr = wid >> 2, wc = wid & 3, fr = lane & 15, fq = lane >> 4;
    const int K = g.K;
    unsigned voffA[2], voffB[2];
#pragma unroll
    for (int i = 0; i < 2; ++i) { int R, C; stage_rc(tid * 16 + i * 8192, R, C); const int Rb = Epi::PERM ? ((R & ~31) + perm32(R & 31)) : R;
        voffA[i] = (unsigned)(R * K + C) * 2u; voffB[i] = (unsigned)(Rb * K + C) * 2u; }
    const unsigned kstep = (unsigned)(BK * 2);
    const unsigned hstep = (unsigned)HALF * K * 2;
    const unsigned tstep = 2 * hstep;
    const unsigned ldsw = (unsigned)wid * 1024u;
    const int aoff = lds_byte(wr * 64 + fr, fq * 8), boff = lds_byte(wc * 32 + fr, fq * 8);
#define PG8_SA(b, h) (((b) * 2 + (h)) * HTB)
#define PG8_SB(b, h) ((4 + (b) * 2 + (h)) * HTB)
    const __amdgpu_buffer_rsrc_t rsA = __builtin_amdgcn_make_buffer_rsrc((void*)g.A, 0, 0x7fffffff, 0x00020000), rsB = __builtin_amdgcn_make_buffer_rsrc((void*)g.Bt, 0, 0x7fffffff, 0x00020000);
#define PG8_RS_voffA rsA
#define PG8_RS_voffB rsB
#define PG8_STAGE(bufoff, goff, voff) do { _Pragma("unroll") for (int _i = 0; _i < 2; ++_i) \
        __builtin_amdgcn_raw_ptr_buffer_load_lds(PG8_RS_##voff, (PG8_LAS void*)(lds + (bufoff) + ldsw + _i * 8192), 16, (voff)[_i], (int)(goff), 0, 0); } while (0)
#define PG8_LDA(dst, b, h) do { _Pragma("unroll") for (int m = 0; m < 4; ++m) FragT<FP8>::load(dst[m], lds + PG8_SA(b, h) + aoff + m * 2048); } while (0)
#define PG8_LDB(dst, b, h) do { _Pragma("unroll") for (int n = 0; n < 2; ++n) FragT<FP8>::load(dst[n], lds + PG8_SB(b, h) + boff + n * 2048); } while (0)
#define PG8_MMA(ai, bj, At, Bt) do { __builtin_amdgcn_s_setprio(1); \
        _Pragma("unroll") for (int m = 0; m < 4; ++m) _Pragma("unroll") for (int n = 0; n < 2; ++n) FragT<FP8>::mma(acc[ai][bj][m][n], Bt[n], At[m], g.sb, g.sa); \
        __builtin_amdgcn_s_setprio(0); } while (0)
#define PG8_WAIT_V(n) asm volatile("s_waitcnt vmcnt(" #n ")" ::: "memory")
#define PG8_WAIT_L(n) asm volatile("s_waitcnt lgkmcnt(" #n ")" ::: "memory")
#define PG8_BAR __builtin_amdgcn_s_barrier()
#define PG8_SCHED __builtin_amdgcn_sched_barrier(0)
    Unit cur, nxt; int ui = 0;
    if (!S.next(0, cur)) return;
    f32x4 acc[2][2][4][2];
#pragma unroll
    for (int a = 0; a < 2; ++a)
#pragma unroll
        for (int b = 0; b < 2; ++b)
#pragma unroll
            for (int m = 0; m < 4; ++m)
#pragma unroll
                for (int n = 0; n < 2; ++n) acc[a][b][m][n] = (f32x4){0.f, 0.f, 0.f, 0.f};
    typename FragT<FP8>::A At[4]; typename FragT<FP8>::A B0[2], B1[2];
    unsigned cA = (unsigned)cur.pm * tstep + (unsigned)cur.k0 * kstep; unsigned cB = (unsigned)cur.pn * tstep + (unsigned)cur.k0 * kstep;
    S.a_ready(cur);
    if constexpr (SP2) {
        PG8_STAGE(PG8_SB(0, 0), cB, voffB); PG8_STAGE(PG8_SB(0, 1), cB + hstep, voffB); PG8_STAGE(PG8_SA(0, 0), cA, voffA); PG8_STAGE(PG8_SA(0, 1), cA + hstep, voffA);
        if (wr == 1) PG8_BAR;
        PG8_WAIT_V(2); PG8_BAR;
        PG8_STAGE(PG8_SB(1, 0), cB + kstep, voffB); PG8_STAGE(PG8_SA(1, 0), cA + kstep, voffA); PG8_STAGE(PG8_SB(1, 1), cB + hstep + kstep, voffB);
        PG8_WAIT_V(6); PG8_BAR;
    } else {
        PG8_STAGE(PG8_SB(0, 0), cB, voffB); PG8_STAGE(PG8_SA(0, 0), cA, voffA); PG8_STAGE(PG8_SB(0, 1), cB + hstep, voffB); PG8_STAGE(PG8_SA(0, 1), cA + hstep, voffA);
        if (wr == 1) PG8_BAR;
        PG8_WAIT_V(4); PG8_BAR;
        PG8_STAGE(PG8_SB(1, 0), cB + kstep, voffB); PG8_STAGE(PG8_SA(1, 0), cA + kstep, voffA); PG8_STAGE(PG8_SB(1, 1), cB + hstep + kstep, voffB);
        PG8_WAIT_V(6); PG8_BAR;
    }
    for (;;) {
        const bool has_next = S.next(ui + 1, nxt);
        const unsigned nA = has_next ? (unsigned)nxt.pm * tstep + (unsigned)nxt.k0 * kstep : cA; const unsigned nB = has_next ? (unsigned)nxt.pn * tstep + (unsigned)nxt.k0 * kstep : cB;
        const int nt = cur.nt;
        for (int t = 0; t < nt; t += 2) {
            const bool last = (t == nt - 2);
            const unsigned a1 = cA + (unsigned)(t + 1) * kstep;
            const unsigned a2 = last ? nA : cA + (unsigned)(t + 2) * kstep; const unsigned b2 = last ? nB : cB + (unsigned)(t + 2) * kstep;
            const unsigned a3 = a2 + kstep; const unsigned b3 = b2 + kstep;
            if (last && has_next) S.a_ready(nxt);
            if constexpr (SP2) {
            PG8_LDB(B0, 0, 0); PG8_LDB(B1, 0, 1); PG8_SCHED; PG8_LDA(At, 0, 0); PG8_STAGE(PG8_SA(1, 1), a1 + hstep, voffA);
            PG8_WAIT_V(8); PG8_WAIT_L(0); PG8_BAR; PG8_MMA(0, 0, At, B0); PG8_MMA(0, 1, At, B1); PG8_BAR; PG8_SCHED;
            PG8_LDA(At, 0, 1); PG8_STAGE(PG8_SB(0, 0), b2, voffB); PG8_STAGE(PG8_SB(0, 1), b2 + hstep, voffB); PG8_STAGE(PG8_SA(0, 0), a2, voffA);
            PG8_WAIT_V(8); PG8_WAIT_L(0); PG8_BAR; PG8_MMA(1, 0, At, B0); PG8_MMA(1, 1, At, B1); PG8_BAR; PG8_SCHED;
            PG8_LDB(B0, 1, 0); PG8_LDB(B1, 1, 1); PG8_SCHED; PG8_LDA(At, 1, 0); PG8_STAGE(PG8_SA(0, 1), a2 + hstep, voffA);
            PG8_WAIT_V(8); PG8_WAIT_L(0); PG8_BAR; PG8_MMA(0, 0, At, B0); PG8_MMA(0, 1, At, B1); PG8_BAR; PG8_SCHED;
            PG8_LDA(At, 1, 1); PG8_STAGE(PG8_SB(1, 0), b3, voffB); PG8_STAGE(PG8_SB(1, 1), b3 + hstep, voffB); PG8_STAGE(PG8_SA(1, 0), a3, voffA);
            PG8_WAIT_V(8); PG8_WAIT_L(0); PG8_BAR; PG8_MMA(1, 0, At, B0); PG8_MMA(1, 1, At, B1); PG8_BAR; PG8_SCHED;
            } else {
            PG8_LDB(B0, 0, 0); PG8_SCHED; PG8_LDA(At, 0, 0); PG8_STAGE(PG8_SA(1, 1), a1 + hstep, voffA);
            PG8_WAIT_L(8); PG8_BAR; PG8_WAIT_L(0); PG8_MMA(0, 0, At, B0); PG8_BAR; PG8_SCHED;
            PG8_LDB(B1, 0, 1); PG8_STAGE(PG8_SB(0, 0), b2, voffB);
            PG8_BAR; PG8_WAIT_L(0); PG8_MMA(0, 1, At, B1); PG8_BAR;
            PG8_LDA(At, 0, 1); PG8_STAGE(PG8_SA(0, 0), a2, voffA);
            PG8_BAR; PG8_WAIT_L(0); PG8_MMA(1, 0, At, B0); PG8_BAR; PG8_SCHED;
            PG8_STAGE(PG8_SB(0, 1), b2 + hstep, voffB);
            PG8_WAIT_V(6); PG8_BAR; PG8_MMA(1, 1, At, B1); PG8_BAR;
            PG8_LDB(B0, 1, 0); PG8_SCHED; PG8_LDA(At, 1, 0); PG8_STAGE(PG8_SA(0, 1), a2 + hstep, voffA);
            PG8_WAIT_L(8); PG8_BAR; PG8_WAIT_L(0); PG8_MMA(0, 0, At, B0); PG8_BAR; PG8_SCHED;
            PG8_LDB(B1, 1, 1); PG8_STAGE(PG8_SB(1, 0), b3, voffB);
            PG8_BAR; PG8_WAIT_L(0); PG8_MMA(0, 1, At, B1); PG8_BAR;
            PG8_LDA(At, 1, 1); PG8_STAGE(PG8_SA(1, 0), a3, voffA);
            PG8_BAR; PG8_WAIT_L(0); PG8_MMA(1, 0, At, B0); PG8_BAR; PG8_SCHED;
            PG8_STAGE(PG8_SB(1, 1), b3 + hstep, voffB);
            PG8_WAIT_V(6); PG8_BAR; PG8_MMA(1, 1, At, B1); PG8_BAR;
            }
        }
        if constexpr (ALIGN_EPI) { if (wr == 0) PG8_BAR; }
        if constexpr (!Epi::AFTER_DRAIN) { const int l2_ = fresh_lane(); const int fr_ = l2_ & 15, fq_ = l2_ >> 4;
            E(acc, cur, wr, wc, fr_, fq_); S.done(cur); }
        if (!has_next) break;
#pragma unroll
        for (int a = 0; a < 2; ++a)
#pragma unroll
            for (int b = 0; b < 2; ++b)
#pragma unroll
                for (int m = 0; m < 4; ++m)
#pragma unroll
                    for (int n = 0; n < 2; ++n) acc[a][b][m][n] = (f32x4){0.f, 0.f, 0.f, 0.f};
        cur = nxt; cA = nA; cB = nB; ++ui;
        if constexpr (ALIGN_EPI) { if (wr == 1) PG8_BAR; }
    }
    PG8_WAIT_V(0);
    if constexpr (!ALIGN_EPI) { if (wr == 0) PG8_BAR; }
    PG8_BAR;
    if constexpr (Epi::AFTER_DRAIN) { E.fused(acc, cur, wr, wc, fr, fq, lds, wid, lane); S.done(cur); }
#undef PG8_SA
#undef PG8_SB
#undef PG8_STAGE
#undef PG8_RS_voffA
#undef PG8_RS_voffB
#undef PG8_LDA
#undef PG8_LDB
#undef PG8_MMA
#undef PG8_WAIT_V
#undef PG8_WAIT_L
#undef PG8_BAR
#undef PG8_SCHED
}
}
constexpr int D = 1024, DFF = 2816, NPROJ = 2304, SEQ = 4096, NBATCH = 4, MP = NBATCH * SEQ, NS = 128, M_REAL = MP + NS, M_PAD = 16640;
constexpr int NMOD = 9 * D;
constexpr float LN_EPS = 1e-5f;
constexpr float ALPHA = 1.189207115002721f;
constexpr float LOG2E = 1.4426950408889634f;
constexpr float QSCALE = 0.125f * LOG2E;
constexpr float NEGV = -1e30f;
constexpr int NWAVES = 8;
#ifndef FP8_UP
#define FP8_UP true
#endif
#ifndef FP8_DOWN
#define FP8_DOWN true
#endif

constexpr size_t MiB = 1u << 20;
constexpr size_t WS_CTL = 0, CTL_ZERO_BYTES = 1 * MiB;
constexpr size_t WS_WGU1 = 2 * MiB, WS_WD1 = 13 * MiB, WS_WIN = 19 * MiB, WS_WOUT = 24 * MiB, WS_WGU2 = 26 * MiB, WS_WD2 = 37 * MiB, WS_WADA = 43 * MiB;
constexpr size_t WS_AMOD = 61 * MiB, WS_MOD = 62 * MiB, WS_SQ = 71 * MiB + 512 * 1024, WS_H = 72 * MiB, WS_ACT = 105 * MiB, WS_Z = 195 * MiB, WS_X1 = 260 * MiB, WS_X2 = 325 * MiB;
constexpr size_t WS_QKV = 390 * MiB, WS_OA = 464 * MiB, WS_LSE = 512 * MiB, WS_MIX = 514 * MiB, WS_SLAB = 548 * MiB, WS_PART = 554 * MiB, WS_END = 555 * MiB;
static_assert(WS_MOD + (size_t)256 * NMOD * 4 <= WS_SQ && WS_SQ + (size_t)NS * 1024 * 4 <= WS_H && WS_H + (size_t)M_PAD * D * 2 <= WS_ACT && WS_ACT + (size_t)M_PAD * DFF * 2 <= WS_Z, "ws map 1");
static_assert(WS_Z + (size_t)M_PAD * D * 4 <= WS_X1 && WS_QKV + (size_t)M_PAD * NPROJ * 2 <= WS_OA && WS_OA + (size_t)3 * MP * 512 * 2 <= WS_LSE && WS_LSE + (size_t)3 * MP * 8 * 4 <= WS_MIX && WS_MIX + (size_t)M_PAD * D * 2 <= WS_SLAB && WS_SLAB + (size_t)11 * 128 * 1024 * 4 <= WS_END, "ws map 2");
constexpr int CW_BAR = 4096;

constexpr int RING_OFF = 0, RING_BYTES = 131072;
constexpr int ATT_TAB_OFF = 147456, ATT_RELS_OFF = 148480;
constexpr int LDSCTL_OFF = 151552, MISC_OFF = LDSCTL_OFF + 320;
constexpr int LDS_BYTES = 155648;

#define GAS __attribute__((address_space(1)))
#define LAS __attribute__((address_space(3)))
typedef unsigned short bf16;
typedef unsigned v4u __attribute__((ext_vector_type(4)));
typedef unsigned v2u __attribute__((ext_vector_type(2)));
typedef float f32x4 __attribute__((ext_vector_type(4)));
typedef short bf16x8 __attribute__((ext_vector_type(8)));
typedef float f32x16 __attribute__((ext_vector_type(16)));
typedef GAS unsigned gu32;
#define RLX_AGENT __ATOMIC_RELAXED, __HIP_MEMORY_SCOPE_AGENT
#define LDS_WAIT() asm volatile("s_waitcnt lgkmcnt(0)" ::: "memory")
__device__ __forceinline__ unsigned f2bf(float f) { unsigned u = __builtin_bit_cast(unsigned, f); return (u + 0x7fffu + ((u >> 16) & 1u)) >> 16; }
__device__ __forceinline__ unsigned pk2(float lo, float hi) { return f2bf(lo) | (f2bf(hi) << 16); }
__device__ __forceinline__ float bf2f(unsigned short b) { return __builtin_bit_cast(float, (unsigned)b << 16); }
#define XB_TMO      128
#define XB_XCNT(j)  (256  + 64 * (j))
#define XB_XSUB(j)  (1280 + 64 * (j))
#define XB_XGEN(j)  (2304 + 64 * (j))
#define XB_TOP      3328
#define XB_TOPGEN   3392
#define XCD_BAR_WORDS 3456
#define XB_SPIN_CAP (1u << 18)

__device__ __forceinline__ unsigned xb_ld(unsigned* p)              { return __hip_atomic_load(p, __ATOMIC_RELAXED, __HIP_MEMORY_SCOPE_AGENT); }
__device__ __forceinline__ unsigned xb_add(unsigned* p, unsigned v) { return __hip_atomic_fetch_add(p, v, __ATOMIC_RELAXED, __HIP_MEMORY_SCOPE_AGENT); }
__device__ __forceinline__ unsigned xb_xcc_id() { return (unsigned)__builtin_amdgcn_s_getreg((3 << 11) | 20) & 0xFu; }
#define XB_SPIN(cond, bar) do { unsigned _sp = 0; while (cond) { __builtin_amdgcn_s_sleep(1); \
    if ((++_sp & 255u) == 0u) { if (xb_ld(&(bar)[XB_TMO])) break; if (_sp > XB_SPIN_CAP) { atomicAdd(&(bar)[XB_TMO], 1u); break; } } } } while (0)

struct XcdBarrier {
    unsigned* bar; unsigned x;
    volatile LAS unsigned* st;
};

__device__ __forceinline__ XcdBarrier xcd_barrier_post(unsigned* bar, volatile LAS unsigned* st) {
    XcdBarrier b; b.bar = bar; b.x = xb_xcc_id(); b.st = st;
    if (threadIdx.x == 0) (void)xb_add(&bar[XB_XCNT(b.x)], 1u);
    return b;
}
__device__ __forceinline__ void xcd_barrier_complete(unsigned* bar, unsigned x, unsigned& nloc, unsigned& nx) {
    const unsigned G = gridDim.x * gridDim.y * gridDim.z;
    unsigned sum, cnt, mine, sp = 0u;
    for (;;) {
        sum = 0u; cnt = 0u; mine = 0u;
#pragma unroll
        for (unsigned j = 0; j < 16; ++j) { const unsigned c = xb_ld(&bar[XB_XCNT(j)]); sum += c; cnt += (c > 0u) ? 1u : 0u; mine = (j == x) ? c : mine; }
        if (sum == G) break;
        __builtin_amdgcn_s_sleep(1);
        if ((++sp & 255u) == 0u) { if (xb_ld(&bar[XB_TMO])) break; if (sp > XB_SPIN_CAP) { atomicAdd(&bar[XB_TMO], 1u); break; } }
    }
    nloc = mine > 0u ? mine : 1u; nx = cnt > 0u ? cnt : 1u;
}

__device__ __forceinline__ void xcd_barrier(const XcdBarrier& b) {
    asm volatile("s_waitcnt vmcnt(0)" ::: "memory");
    __syncthreads();
    if (threadIdx.x == 0) {
        unsigned* bar = b.bar;
        __builtin_amdgcn_s_waitcnt(0);
        unsigned nloc = b.st[0], nx = b.st[1];
        if (nloc == 0u) { xcd_barrier_complete(bar, b.x, nloc, nx); b.st[0] = nloc; b.st[1] = nx; }
        const unsigned old = xb_add(&bar[XB_XSUB(b.x)], 1u);
        const unsigned gen = old / nloc;
        if (old + 1u == (gen + 1u) * nloc) {
            __builtin_amdgcn_fence(__ATOMIC_RELEASE, "agent");
            asm volatile("s_waitcnt vmcnt(0)" ::: "memory");
            const unsigned og = xb_add(&bar[XB_TOP], 1u);
            const unsigned tg = og / nx;
            if (og + 1u == (tg + 1u) * nx) xb_add(&bar[XB_TOPGEN], 1u);
            else XB_SPIN(xb_ld(&bar[XB_TOPGEN]) == tg, bar);
            __builtin_amdgcn_fence(__ATOMIC_ACQUIRE, "agent");
            xb_add(&bar[XB_XGEN(b.x)], 1u);
            asm volatile("s_waitcnt vmcnt(0)" ::: "memory");
        } else {
            XB_SPIN(xb_ld(&bar[XB_XGEN(b.x)]) == gen, bar);
            __builtin_amdgcn_fence(__ATOMIC_ACQUIRE, "agent");
            asm volatile("s_waitcnt vmcnt(0)" ::: "memory");
        }
    }
    __syncthreads();
}
struct Args { const float* in[22]; float* out; unsigned char* ws; };
struct Frame {
    LAS unsigned char* lds;
    int tid, lane, wave, vcu, G;
};
__device__ __forceinline__ float wave_sum(float v) {
#pragma unroll
    for (int o = 1; o < 64; o <<= 1) v += __shfl_xor(v, o);
    return v;
}
__device__ __forceinline__ float wave_max(float v) {
#pragma unroll
    for (int o = 1; o < 64; o <<= 1) v = fmaxf(v, __shfl_xor(v, o));
    return v;
}
template <bool F8>
__device__ __forceinline__ void p0_transpose_item(const float* W, int K, int N, bf16* WT, int k0, int n0, int drow0, float wscale, LAS float* scr, int lane) {
#pragma unroll 8
    for (int i = 0; i < 32; ++i) { const int kk = 2 * i + (lane >> 5); scr[kk * 33 + (lane & 31)] = W[(size_t)(k0 + kk) * N + n0 + (lane & 31)]; }
    LDS_WAIT(); asm volatile("" ::: "memory");
    const int c = lane & 7;
#pragma unroll
    for (int j = 0; j < 4; ++j) { const int n = (lane >> 3) + 8 * j; const LAS float* s = scr + (8 * c) * 33 + n;
        if constexpr (F8) { v2u o; o.x = pg8::pk4_fp8(s[0 * 33] * wscale, s[1 * 33] * wscale, s[2 * 33] * wscale, s[3 * 33] * wscale); o.y = pg8::pk4_fp8(s[4 * 33] * wscale, s[5 * 33] * wscale, s[6 * 33] * wscale, s[7 * 33] * wscale);
            *(GAS v2u*)((unsigned char*)WT + (size_t)(drow0 + n) * K + k0 + 8 * c) = o; }
        else { v4u o; o.x = pk2(s[0 * 33], s[1 * 33]); o.y = pk2(s[2 * 33], s[3 * 33]); o.z = pk2(s[4 * 33], s[5 * 33]); o.w = pk2(s[6 * 33], s[7 * 33]);
        *(GAS v4u*)(WT + (size_t)(drow0 + n) * K + k0 + 8 * c) = o; } }
    LDS_WAIT(); asm volatile("" ::: "memory");
}
template <bool GU, bool F8>
__device__ __forceinline__ bool p0_matrix(int& r, const float* W, int K, int N, bf16* WT, int half, float wscale, LAS float* scr, int lane) {
    const int nblk = N / 32, items = (K / 64) * nblk;
    if (r >= items) { r -= items; return false; }
    const int kb = r / nblk, nb = r % nblk, n0 = 32 * nb;
    const int drow0 = GU ? (256 * (n0 >> 7) + (n0 & 127) + half * 128) : n0;
    p0_transpose_item<F8>(W, K, N, WT, 64 * kb, n0, drow0, wscale, scr, lane);
    return true;
}
__device__ __forceinline__ int seq_of_row(int row) { return row < MP ? (row >> 12) : (4 + row - MP); }

typedef float f32x2_t __attribute__((ext_vector_type(2))); typedef __bf16 bf16x2_t __attribute__((ext_vector_type(2)));
__device__ __forceinline__ unsigned cvtpk(float lo, float hi) { f32x2_t v = {lo, hi}; bf16x2_t b = __builtin_convertvector(v, bf16x2_t); return __builtin_bit_cast(unsigned, b); }
#define PACK8(X, S) __builtin_bit_cast(bf16x8, (v4u){cvtpk((X)[8 * (S) + 0], (X)[8 * (S) + 1]), cvtpk((X)[8 * (S) + 2], (X)[8 * (S) + 3]), cvtpk((X)[8 * (S) + 4], (X)[8 * (S) + 5]), cvtpk((X)[8 * (S) + 6], (X)[8 * (S) + 7])})
__device__ __forceinline__ int t5_bucket(int n) {
    if (n < 16) return n;
    int b = 16;
    b += (n >= 22); b += (n >= 30); b += (n >= 40); b += (n >= 54); b += (n >= 73); b += (n >= 99); b += (n >= 134); b += (n >= 182);
    b += (n >= 246); b += (n >= 332); b += (n >= 450); b += (n >= 609); b += (n >= 825); b += (n >= 1117); b += (n >= 1513);
    return b;
}
__device__ __forceinline__ void band_task(const bf16* Qb, const bf16* Kb, const bf16* Vb, size_t stride, int j0, const LAS float* tab, bool has_sink, float sink2,
                                          f32x16 (&o)[2], float& lse2) {
    const int lane = pg8::fresh_lane(), q = lane & 31, hi = lane >> 5;
    const int pr = (q & ~12) | ((q & 4) << 1) | ((q & 8) >> 1);
    const int tb = 8 * hi - q + 31;
    bf16x8 qf[4], kf[5][4];
    { const bf16* qrow = Qb + (size_t)(j0 + q) * stride + 8 * hi;
#pragma unroll
      for (int d0 = 0; d0 < 4; ++d0) qf[d0] = *(const bf16x8*)(qrow + 16 * d0); }
#pragma unroll
    for (int kt = 0; kt < 5; ++kt) {
        int jj = j0 - 128 + 32 * kt + pr; jj = jj < 0 ? 0 : jj;
        const bf16* krow = Kb + (size_t)jj * stride + 8 * hi;
#pragma unroll
        for (int d0 = 0; d0 < 4; ++d0) kf[kt][d0] = *(const bf16x8*)(krow + 16 * d0);
    }
    f32x16 s[5];
#pragma unroll
    for (int kt = 0; kt < 5; ++kt) {
        f32x16 c;
#pragma unroll
        for (int r = 0; r < 16; ++r) c[r] = tab[tb + 32 * kt + 16 * (r >> 3) + (r & 7)];
#pragma unroll
        for (int d0 = 0; d0 < 4; ++d0) c = __builtin_amdgcn_mfma_f32_32x32x16_bf16(kf[kt][d0], qf[d0], c, 0, 0, 0);
        if (j0 < 128) {
#pragma unroll
            for (int r = 0; r < 16; ++r) { const int jr = j0 - 128 + 32 * kt + 16 * (r >> 3) + 8 * hi + (r & 7); if (jr < 0) c[r] = NEGV; }
        }
        s[kt] = c;
    }
    bf16x8 vf[5][4];
#pragma unroll
    for (int kt = 0; kt < 5; ++kt) {
        int jj = j0 - 128 + 32 * kt + pr; jj = jj < 0 ? 0 : jj;
        const bf16* vrow = Vb + (size_t)jj * stride + 8 * hi;
#pragma unroll
        for (int d0 = 0; d0 < 4; ++d0) vf[kt][d0] = *(const bf16x8*)(vrow + 16 * d0);
    }
    float m = s[0][0];
#pragma unroll
    for (int kt = 0; kt < 5; ++kt)
#pragma unroll
        for (int r = 0; r < 16; ++r) m = fmaxf(m, s[kt][r]);
    m = fmaxf(m, __shfl_xor(m, 32));
    if (has_sink) m = fmaxf(m, sink2);
    float den = 0.f;
#pragma unroll
    for (int kt = 0; kt < 5; ++kt)
#pragma unroll
        for (int r = 0; r < 16; ++r) { const float p = __builtin_amdgcn_exp2f(s[kt][r] - m); s[kt][r] = p; den += p; }
    den += __shfl_xor(den, 32);
    if (has_sink) den += __builtin_amdgcn_exp2f(sink2 - m);
    bf16x8 I0, I1;
#pragma unroll
    for (int j = 0; j < 8; ++j) { const bool on = (((q >> 3) & 1) == hi) && ((q & 7) == j);
        I0[j] = (on && (q >> 4) == 0) ? (short)0x3F80 : (short)0; I1[j] = (on && (q >> 4) == 1) ? (short)0x3F80 : (short)0; }
    o[0] = (f32x16){}; o[1] = (f32x16){};
#pragma unroll
    for (int kt = 0; kt < 5; ++kt) {
        f32x16 X0 = (f32x16){}, X1 = (f32x16){};
        X0 = __builtin_amdgcn_mfma_f32_32x32x16_bf16(vf[kt][0], I0, X0, 0, 0, 0); X0 = __builtin_amdgcn_mfma_f32_32x32x16_bf16(vf[kt][1], I1, X0, 0, 0, 0);
        X1 = __builtin_amdgcn_mfma_f32_32x32x16_bf16(vf[kt][2], I0, X1, 0, 0, 0); X1 = __builtin_amdgcn_mfma_f32_32x32x16_bf16(vf[kt][3], I1, X1, 0, 0, 0);
        { const bf16x8 pa = PACK8(s[kt], 0); o[0] = __builtin_amdgcn_mfma_f32_32x32x16_bf16(PACK8(X0, 0), pa, o[0], 0, 0, 0); o[1] = __builtin_amdgcn_mfma_f32_32x32x16_bf16(PACK8(X1, 0), pa, o[1], 0, 0, 0); }
        { const bf16x8 pa = PACK8(s[kt], 1); o[0] = __builtin_amdgcn_mfma_f32_32x32x16_bf16(PACK8(X0, 1), pa, o[0], 0, 0, 0); o[1] = __builtin_amdgcn_mfma_f32_32x32x16_bf16(PACK8(X1, 1), pa, o[1], 0, 0, 0); }
    }
    const float inv = 1.0f / den;
#pragma unroll
    for (int r = 0; r < 16; ++r) { o[0][r] *= inv; o[1][r] *= inv; }
    lse2 = m + __builtin_log2f(den);
}
__device__ __forceinline__ float dppf(float x, int ctrl_quad_b1) { return x; }
#define DPP_ADD(x, CTRL) ((x) + __builtin_bit_cast(float, __builtin_amdgcn_update_dpp(0, __builtin_bit_cast(int, (x)), (CTRL), 0xF, 0xF, true)))
__device__ __forceinline__ float row16_sum(float x) {
    x = DPP_ADD(x, 0xB1);
    x = DPP_ADD(x, 0x4E);
    x = DPP_ADD(x, 0x141);
    x = DPP_ADD(x, 0x140);
    return x;
}
__device__ __forceinline__ int sa_dist(int v) { return v < 129 ? v : (v < 225 ? 128 + 4 * (v - 128) : 512 + 16 * (v - 224)); }
__device__ __forceinline__ void sampleA_wave(int n, int hf, int w, const float* sq, const LAS float* tabS, const float* cache_k, const float* cache_v, const float* own_k, const float* own_v, LAS float* PS) {
    const int lane = pg8::fresh_lane(), hd0 = lane >> 4, dq = 4 * (lane & 15);
    const f32x4 q0 = *(const f32x4*)(sq + (size_t)n * 1024 + hd0 * 64 + dq), q1 = *(const f32x4*)(sq + (size_t)n * 1024 + (4 + hd0) * 64 + dq);
    const float* ckn = cache_k + (size_t)n * 2048 * 512 + 4 * lane; const float* cvn = cache_v + (size_t)n * 2048 * 512 + 4 * lane;
    const float* okn = own_k + (size_t)n * 512 + 4 * lane; const float* ovn = own_v + (size_t)n * 512 + 4 * lane;
    float m0 = NEGV, m1 = NEGV, den0 = 0.f, den1 = 0.f; f32x4 o0 = (f32x4){0.f, 0.f, 0.f, 0.f}, o1 = o0;
#pragma unroll 1
    for (int c = 0; c < 3; ++c) {
        f32x4 kA[7], kB[7], vA[7], vB[7]; float s0[7], s1[7];
#pragma unroll
        for (int j = 0; j < 7; ++j) { const int v = hf + 2 * (w + 8 * (7 * c + j));
            if (v < 321) { const int dl = sa_dist(v); const float* kp = dl == 0 ? okn : ckn + (size_t)(2048 - dl) * 512; const float* vp = dl == 0 ? ovn : cvn + (size_t)(2048 - dl) * 512;
                kA[j] = *(const f32x4*)kp; kB[j] = *(const f32x4*)(kp + 256); vA[j] = *(const f32x4*)vp; vB[j] = *(const f32x4*)(vp + 256); } }
        float mx0 = m0, mx1 = m1;
#pragma unroll
        for (int j = 0; j < 7; ++j) { const int v = hf + 2 * (w + 8 * (7 * c + j)); s0[j] = NEGV; s1[j] = NEGV;
            if (v < 321) { const int dl = sa_dist(v);
                const float d0 = row16_sum((kA[j][0] * q0[0] + kA[j][1] * q0[1]) + (kA[j][2] * q0[2] + kA[j][3] * q0[3]));
                const float d1 = row16_sum((kB[j][0] * q1[0] + kB[j][1] * q1[1]) + (kB[j][2] * q1[2] + kB[j][3] * q1[3]));
                const int mult = (dl <= 128 ? 1 : 0) + ((dl <= 512 && (dl & 3) == 0) ? 1 : 0) + ((dl & 15) == 0 ? 1 : 0);
                const float lm = mult == 3 ? 1.5849625007211562f : (mult == 2 ? 1.0f : 0.f);
                const int bk = t5_bucket(dl) * 16;
                s0[j] = d0 + tabS[bk + hd0] + lm; s1[j] = d1 + tabS[bk + 4 + hd0] + lm; mx0 = fmaxf(mx0, s0[j]); mx1 = fmaxf(mx1, s1[j]); } }
        const float c0 = __builtin_amdgcn_exp2f(m0 - mx0), c1 = __builtin_amdgcn_exp2f(m1 - mx1);
        den0 *= c0; den1 *= c1; o0 = o0 * c0; o1 = o1 * c1; m0 = mx0; m1 = mx1;
#pragma unroll
        for (int j = 0; j < 7; ++j) { const int v = hf + 2 * (w + 8 * (7 * c + j));
            if (v < 321) { const float p0 = __builtin_amdgcn_exp2f(s0[j] - mx0), p1 = __builtin_amdgcn_exp2f(s1[j] - mx1); den0 += p0; den1 += p1; o0 += vA[j] * p0; o1 += vB[j] * p1; } }
    }
    LAS float* ps = PS + (w * 64 + lane) * 12;
    ps[0] = m0; ps[1] = den0; ps[2] = o0[0]; ps[3] = o0[1]; ps[4] = o0[2]; ps[5] = o0[3]; ps[6] = m1; ps[7] = den1; ps[8] = o1[0]; ps[9] = o1[1]; ps[10] = o1[2]; ps[11] = o1[3];
}
__device__ __forceinline__ void sampleA_combine(int n, int hf, int tid, const LAS float* PS, float* PARTO, float* PARTM, float* PARTD) {
    if (tid < 128) { const int X = tid >> 6, l = tid & 63;
        float M = NEGV;
#pragma unroll
        for (int w = 0; w < 8; ++w) M = fmaxf(M, PS[(w * 64 + l) * 12 + 6 * X]);
        float den = 0.f; f32x4 o = (f32x4){0.f, 0.f, 0.f, 0.f};
#pragma unroll
        for (int w = 0; w < 8; ++w) { const LAS float* p = PS + (w * 64 + l) * 12 + 6 * X; const float e = __builtin_amdgcn_exp2f(p[0] - M); den += p[1] * e; o += (f32x4){p[2], p[3], p[4], p[5]} * e; }
        *(f32x4*)(PARTO + (size_t)(2 * n + hf) * 512 + 256 * X + 4 * l) = o;
        if ((l & 15) == 0) { PARTM[(2 * n + hf) * 8 + 4 * X + (l >> 4)] = M; PARTD[(2 * n + hf) * 8 + 4 * X + (l >> 4)] = den; } }
}

struct AUnit { const bf16 *Q, *K, *V; size_t stride; int J0, type, h, token0, dil; };
__device__ __forceinline__ AUnit attn_decode_unit(int U, const bf16* QKVp) {
    AUnit u; const int type = U >> 9, rem = U & 511, h = rem & 7, x2 = rem >> 3, b = x2 >> 4, y2 = x2 & 15;
    const int dil = type == 1 ? 4 : (type == 2 ? 16 : 1), gpc = 16 / dil, rc = y2 / gpc, g8 = y2 % gpc;
    const bf16* base = QKVp + (size_t)(b * SEQ + rc) * NPROJ;
    if (type < 3) { u.Q = base + h * 64; u.K = base + 512 + h * 64; u.V = base + 1024 + h * 64; }
    else { u.Q = base + 1536 + h * 64; u.K = base + 2048 + (h >> 2) * 64; u.V = base + 2176 + (h >> 2) * 64; }
    u.stride = (size_t)dil * NPROJ; u.J0 = 256 * g8; u.type = type; u.h = h; u.token0 = b * SEQ + rc; u.dil = dil; return u;
}
__device__ __forceinline__ void attn_dma_rows(const bf16* G, size_t stride, int Jfirst, LAS unsigned char* buf, int w, int lane) {
    const int r8 = lane >> 3, slot = lane & 7;
#pragma unroll
    for (int i = 0; i < 6; ++i) { const int p = w + 8 * i; int jj = Jfirst + 8 * p + r8; jj = jj < 0 ? 0 : jj;
        const int c = slot ^ ((4 * p + (r8 >> 1)) & 7);
        __builtin_amdgcn_global_load_lds((const unsigned*)(G + (size_t)jj * stride + 8 * c), (LAS unsigned*)(buf + p * 1024), 16, 0, 0); }
}
#define AT_WAITV(n) asm volatile("s_waitcnt vmcnt(" #n ")" ::: "memory")
#define AT_BAR() do { asm volatile("s_waitcnt lgkmcnt(0)" ::: "memory"); __builtin_amdgcn_s_barrier(); asm volatile("" ::: "memory"); } while (0)
__device__ __forceinline__ void attn_load_q(bf16x8 (&qf)[4], const bf16* qrow) {
    asm volatile("global_load_dwordx4 %0, %1, off" : "=&v"(qf[0]) : "v"(qrow) : "memory");
    asm volatile("global_load_dwordx4 %0, %1, off offset:32" : "=&v"(qf[1]) : "v"(qrow) : "memory");
    asm volatile("global_load_dwordx4 %0, %1, off offset:64" : "=&v"(qf[2]) : "v"(qrow) : "memory");
    asm volatile("global_load_dwordx4 %0, %1, off offset:96" : "=&v"(qf[3]) : "v"(qrow) : "memory");
}
#define AT_WAITV_Q(n) asm volatile("s_waitcnt vmcnt(" #n ")" : "+v"(qf[0]), "+v"(qf[1]), "+v"(qf[2]), "+v"(qf[3]) :: "memory")
__device__ __forceinline__ void attn_units(LAS unsigned char* lds, int w, int vcu, int G, const bf16* QKVp, bf16* OAp, float* LSEp, bf16* MIXp) {
    const int lane = pg8::fresh_lane(), q = lane & 31, hi = lane >> 5;
    const int pr = (q & ~12) | ((q & 4) << 1) | ((q & 8) >> 1), f = (pr >> 1) & 7, tb = 8 * hi - q + 31;
    LAS unsigned char* VB = lds + 98304; LAS float* tab = (LAS float*)(lds + ATT_TAB_OFF); const LAS float* relS = (const LAS float*)(lds + ATT_RELS_OFF);
    const int nU = (2048 - vcu + G - 1) / G;
    bf16x8 I0, I1;
#pragma unroll
    for (int j = 0; j < 8; ++j) { const bool on = (((q >> 3) & 1) == hi) && ((q & 7) == j);
        I0[j] = (on && (q >> 4) == 0) ? (short)0x3F80 : (short)0; I1[j] = (on && (q >> 4) == 1) ? (short)0x3F80 : (short)0; }
    AUnit u = attn_decode_unit(vcu, QKVp);
    bf16x8 qf[4];
    attn_load_q(qf, u.Q + (size_t)(u.J0 + 32 * w + q) * u.stride + 8 * hi);
    attn_dma_rows(u.K, u.stride, u.J0 - 128, lds, w, lane);
    attn_dma_rows(u.V, u.stride, u.J0 - 128, VB, w, lane);
    if (nU > 1) { const AUnit u1 = attn_decode_unit(vcu + G, QKVp); attn_dma_rows(u1.K, u1.stride, u1.J0 - 128, lds + 49152, w, lane); }
#pragma unroll 1
    for (int i = 0; i < nU; ++i) {
        LAS unsigned char* Kb = lds + (i & 1) * 49152;
        { const int t = w * 64 + lane; if (t < 192) { const int dist = 159 - t; float v = NEGV;
            if (dist >= 0 && dist <= 128) v = relS[t5_bucket(dist * u.dil) * 16 + (u.type == 3 ? 8 + u.h : u.h)];
            tab[t] = v; } }
        if (i + 1 < nU) AT_WAITV_Q(12); else AT_WAITV_Q(6);
        AT_BAR();
        const int j0 = u.J0 + 32 * w;
        f32x16 s[5];
#pragma unroll
        for (int kt = 0; kt < 5; ++kt) {
            const LAS unsigned char* krow = Kb + (32 * (w + kt) + pr) * 128;
            f32x16 c;
#pragma unroll
            for (int r = 0; r < 16; ++r) c[r] = tab[tb + 32 * kt + 16 * (r >> 3) + (r & 7)];
#pragma unroll
            for (int d0 = 0; d0 < 4; ++d0) { const bf16x8 kf = *(const LAS bf16x8*)(krow + (((2 * d0 + hi) ^ f) << 4)); c = __builtin_amdgcn_mfma_f32_32x32x16_bf16(kf, qf[d0], c, 0, 0, 0); }
            if (j0 < 128) {
#pragma unroll
                for (int r = 0; r < 16; ++r) { const int jr = j0 - 128 + 32 * kt + 16 * (r >> 3) + 8 * hi + (r & 7); if (jr < 0) c[r] = NEGV; }
            }
            s[kt] = c;
        }
        AUnit un = u;
        if (i + 1 < nU) { un = attn_decode_unit(vcu + (i + 1) * G, QKVp); attn_load_q(qf, un.Q + (size_t)(un.J0 + 32 * w + q) * un.stride + 8 * hi); }
        const bool has_sink = u.type == 3; const float sink2 = relS[512 + u.h];
        float m = s[0][0];
#pragma unroll
        for (int kt = 0; kt < 5; ++kt)
#pragma unroll
            for (int r = 0; r < 16; ++r) m = fmaxf(m, s[kt][r]);
        m = fmaxf(m, __shfl_xor(m, 32));
        if (has_sink) m = fmaxf(m, sink2);
        float den = 0.f;
#pragma unroll
        for (int kt = 0; kt < 5; ++kt)
#pragma unroll
            for (int r = 0; r < 16; ++r) { const float p = __builtin_amdgcn_exp2f(s[kt][r] - m); s[kt][r] = p; den += p; }
        den += __shfl_xor(den, 32);
        if (has_sink) den += __builtin_amdgcn_exp2f(sink2 - m);
        if (i + 1 < nU) AT_WAITV(10); else AT_WAITV(0);
        AT_BAR();
        f32x16 o[2]; o[0] = (f32x16){}; o[1] = (f32x16){};
#pragma unroll
        for (int kt = 0; kt < 5; ++kt) {
            const LAS unsigned char* vrow = VB + (32 * (w + kt) + pr) * 128;
            bf16x8 vf[4];
#pragma unroll
            for (int d0 = 0; d0 < 4; ++d0) vf[d0] = *(const LAS bf16x8*)(vrow + (((2 * d0 + hi) ^ f) << 4));
            f32x16 X0 = (f32x16){}, X1 = (f32x16){};
            X0 = __builtin_amdgcn_mfma_f32_32x32x16_bf16(vf[0], I0, X0, 0, 0, 0); X0 = __builtin_amdgcn_mfma_f32_32x32x16_bf16(vf[1], I1, X0, 0, 0, 0);
            X1 = __builtin_amdgcn_mfma_f32_32x32x16_bf16(vf[2], I0, X1, 0, 0, 0); X1 = __builtin_amdgcn_mfma_f32_32x32x16_bf16(vf[3], I1, X1, 0, 0, 0);
            { const bf16x8 pa = PACK8(s[kt], 0); o[0] = __builtin_amdgcn_mfma_f32_32x32x16_bf16(PACK8(X0, 0), pa, o[0], 0, 0, 0); o[1] = __builtin_amdgcn_mfma_f32_32x32x16_bf16(PACK8(X1, 0), pa, o[1], 0, 0, 0); }
            { const bf16x8 pa = PACK8(s[kt], 1); o[0] = __builtin_amdgcn_mfma_f32_32x32x16_bf16(PACK8(X0, 1), pa, o[0], 0, 0, 0); o[1] = __builtin_amdgcn_mfma_f32_32x32x16_bf16(PACK8(X1, 1), pa, o[1], 0, 0, 0); }
        }
        const float inv = 1.0f / den;
        const int token = u.token0 + u.dil * (j0 + q);
        bf16* dst = u.type < 3 ? OAp + ((size_t)u.type * MP + token) * 512 + u.h * 64 : MIXp + (size_t)token * D + 512 + u.h * 64;
#pragma unroll
        for (int nb = 0; nb < 2; ++nb)
#pragma unroll
            for (int g4 = 0; g4 < 4; ++g4) { v2u wv; wv.x = cvtpk(o[nb][4 * g4 + 0] * inv, o[nb][4 * g4 + 1] * inv); wv.y = cvtpk(o[nb][4 * g4 + 2] * inv, o[nb][4 * g4 + 3] * inv);
                *(v2u*)(dst + 32 * nb + 8 * g4 + 4 * hi) = wv; }
        if (u.type < 3 && hi == 0) LSEp[((size_t)u.type * MP + token) * 8 + u.h] = m + __builtin_log2f(den);
        AT_BAR();
        if (i + 1 < nU) {
            u = un;
            attn_dma_rows(u.V, u.stride, u.J0 - 128, VB, w, lane);
            if (i + 2 < nU) { const AUnit u2 = attn_decode_unit(vcu + (i + 2) * G, QKVp); attn_dma_rows(u2.K, u2.stride, u2.J0 - 128, Kb, w, lane); }
        }
    }
}
__device__ __forceinline__ void sample_task(bool isB, int n, int h, const float* sq, const float* rel_bias, const float* sinks,
                                            const float* cache_k, const float* cache_v, const float* own_k, const float* own_v, bf16* mix, LAS float* pbuf) {
    const int lane = pg8::fresh_lane();
    f32x4 qv[16];
    { const f32x4* qp = (const f32x4*)(sq + (size_t)n * 1024 + (isB ? 512 : 0) + h * 64);
#pragma unroll
      for (int i = 0; i < 16; ++i) qv[i] = qp[i]; }
    const int nvis = isB ? 129 : 321, npass = isB ? 3 : 6;
    const int rowstride = isB ? 128 : 512, nrows = isB ? 128 : 2048, hcol = isB ? (h >> 2) * 64 : h * 64;
    const float* ck = cache_k + (size_t)n * nrows * rowstride + hcol;
    const float* cv = cache_v + (size_t)n * nrows * rowstride + hcol;
    const float* ok = own_k + (size_t)n * rowstride + hcol;
    const float* ov = own_v + (size_t)n * rowstride + hcol;
    const int bcol = isB ? 8 + h : h;
    float lmax = NEGV;
#pragma unroll 2
    for (int pass = 0; pass < npass; ++pass) {
        const int v = pass * 64 + lane; const bool valid = v < nvis;
        int dl = isB ? v : (v < 129 ? v : (v < 225 ? 128 + 4 * (v - 128) : 512 + 16 * (v - 224)));
        if (!valid) dl = 0;
        const f32x4* kp = (const f32x4*)(dl == 0 ? ok : ck + (size_t)(nrows - dl) * rowstride);
        float dot = 0.f;
#pragma unroll
        for (int i = 0; i < 16; ++i) { const f32x4 kk = kp[i]; dot += (kk[0] * qv[i][0] + kk[1] * qv[i][1]) + (kk[2] * qv[i][2] + kk[3] * qv[i][3]); }
        float lm = 0.f;
        if (!isB) { const int mult = (dl <= 128 ? 1 : 0) + ((dl <= 512 && (dl & 3) == 0) ? 1 : 0) + ((dl & 15) == 0 ? 1 : 0); lm = mult == 3 ? 1.5849625007211562f : (mult == 2 ? 1.0f : 0.f); }
        float s = dot + rel_bias[t5_bucket(dl) * 16 + bcol] * LOG2E + lm;
        s = valid ? s : NEGV;
        pbuf[v] = s; lmax = fmaxf(lmax, s);
    }
    float m = wave_max(lmax);
    const float sink2 = isB ? sinks[h] * LOG2E : NEGV;
    if (isB) m = fmaxf(m, sink2);
    float den = 0.f;
    LDS_WAIT(); asm volatile("" ::: "memory");
#pragma unroll 1
    for (int pass = 0; pass < npass; ++pass) { const int v = pass * 64 + lane; const float p = __builtin_amdgcn_exp2f(pbuf[v] - m); den += p; pbuf[v] = p; }
    den = wave_sum(den);
    if (isB) den += __builtin_amdgcn_exp2f(sink2 - m);
    LDS_WAIT(); asm volatile("" ::: "memory");
    const int dch = lane & 15, g = lane >> 4;
    f32x4 acc = (f32x4){0.f, 0.f, 0.f, 0.f};
    const int nit = (nvis + 3) >> 2;
#pragma unroll 16
    for (int it = 0; it < nit; ++it) {
        const int v = 4 * it + g;
        if (v < nvis) {
            const int dl = isB ? v : (v < 129 ? v : (v < 225 ? 128 + 4 * (v - 128) : 512 + 16 * (v - 224)));
            const float* vp = dl == 0 ? ov : cv + (size_t)(nrows - dl) * rowstride;
            const f32x4 val = *(const f32x4*)(vp + 4 * dch);
            acc += val * pbuf[v];
        }
    }
#pragma unroll
    for (int e = 0; e < 4; ++e) { float t = acc[e]; t += __shfl_xor(t, 16); t += __shfl_xor(t, 32); acc[e] = t; }
    LDS_WAIT(); asm volatile("" ::: "memory");
    if (g == 0) { const float inv = 1.0f / den; v2u w; w.x = pk2(acc[0] * inv, acc[1] * inv); w.y = pk2(acc[2] * inv, acc[3] * inv);
        *(v2u*)(mix + (size_t)(MP + n) * D + (isB ? 512 : 0) + h * 64 + 4 * dch) = w; }
}

template <int HMODE  , int NSLAB>
__device__ __forceinline__ void ln_rows(const Frame& F, const float* xp, const float* xs, const float* Z, const float* SLAB, const float* MOD, int gc, float gs, const float* lng, const float* lnb,
                                        float* outp, bf16* Hout, int shc, int scc) {
    const int gw = F.vcu * NWAVES + F.wave, NGW = F.G * NWAVES;
    for (int row = gw; row < M_REAL; row += NGW) {
        const int seq = seq_of_row(row);
        const f32x4* xr = (const f32x4*)(row < MP ? xp + (size_t)row * D : xs + (size_t)(row - MP) * D) + F.lane;
        const f32x4* mr = (const f32x4*)(MOD + (size_t)seq * NMOD) + F.lane;
        f32x4 a[4]; float s = 0.f;
        if (row < MP) {
            const v2u* zr = (const v2u*)((const bf16*)Z + (size_t)row * D) + F.lane;
#pragma unroll
            for (int j = 0; j < 4; ++j) { const v2u z2 = zr[64 * j]; a[j] = (f32x4){bf2f((unsigned short)(z2.x & 0xffffu)), bf2f((unsigned short)(z2.x >> 16)), bf2f((unsigned short)(z2.y & 0xffffu)), bf2f((unsigned short)(z2.y >> 16))}; }
        } else {
            const f32x4* zr = (const f32x4*)(SLAB + (size_t)(row - MP) * D) + F.lane;
            f32x4 t[NSLAB][4];
#pragma unroll
            for (int sl = 0; sl < NSLAB; ++sl)
#pragma unroll
                for (int j = 0; j < 4; ++j) t[sl][j] = zr[(size_t)sl * (128 * 256) + 64 * j];
#pragma unroll
            for (int j = 0; j < 4; ++j) { a[j] = t[0][j];
#pragma unroll
                for (int sl = 1; sl < NSLAB; ++sl) a[j] += t[sl][j]; }
        }
#pragma unroll
        for (int j = 0; j < 4; ++j) { a[j] = xr[64 * j] * ALPHA + (mr[gc * 256 + 64 * j] * gs) * a[j]; s += (a[j][0] + a[j][1]) + (a[j][2] + a[j][3]); }
        const float mean = wave_sum(s) * (1.f / D); float s2 = 0.f;
#pragma unroll
        for (int j = 0; j < 4; ++j) { a[j] = a[j] - mean; s2 += (a[j][0] * a[j][0] + a[j][1] * a[j][1]) + (a[j][2] * a[j][2] + a[j][3] * a[j][3]); }
        const float rstd = 1.f / sqrtf(wave_sum(s2) * (1.f / D) + LN_EPS);
        f32x4* orow = (f32x4*)(outp + (size_t)row * D) + F.lane;
        v2u* hrow = (v2u*)(Hout + (size_t)row * D) + F.lane; unsigned* hrow8 = (unsigned*)((unsigned char*)Hout + (size_t)row * D) + F.lane;
#pragma unroll
        for (int j = 0; j < 4; ++j) { const f32x4 o = a[j] * rstd * ((const f32x4*)lng)[F.lane + 64 * j] + ((const f32x4*)lnb)[F.lane + 64 * j];
            orow[64 * j] = o;
            if (HMODE != 0) { const f32x4 hh = o * (mr[scc * 256 + 64 * j] + 1.0f) + mr[shc * 256 + 64 * j];
                if (HMODE == 2) hrow8[64 * j] = pg8::pk4_fp8(hh[0], hh[1], hh[2], hh[3]);
                else { v2u w; w.x = pk2(hh[0], hh[1]); w.y = pk2(hh[2], hh[3]); hrow[64 * j] = w; } } }
    }
}

__global__ void __launch_bounds__(NWAVES * 64, 2) mega_fwd(Args args) {
    extern __shared__ __attribute__((aligned(16))) unsigned char lds[];
    Frame F;
    F.lds = (LAS unsigned char*)lds;
    volatile LAS unsigned* MISC = (volatile LAS unsigned*)(F.lds + MISC_OFF);
    F.tid = threadIdx.x; F.lane = F.tid & 63; F.wave = __builtin_amdgcn_readfirstlane(F.tid >> 6);
    F.G = gridDim.x; { const int bx = blockIdx.x; F.vcu = (F.G % 8 == 0) ? (bx % 8) * (F.G / 8) + bx / 8 : bx; }
    gu32* ctl = (gu32*)(args.ws + WS_CTL);
    for (int u = F.tid; u < (LDS_BYTES - LDSCTL_OFF) / 4; u += NWAVES * 64) ((LAS unsigned*)(F.lds + LDSCTL_OFF))[u] = 0u;
    __syncthreads();
    XcdBarrier bar = xcd_barrier_post((unsigned*)(ctl + CW_BAR), MISC + 8);
    const int gw = F.vcu * NWAVES + F.wave, NGW = F.G * NWAVES;
#define REFRESH() do { F.lane = pg8::fresh_lane(); F.tid = F.wave * 64 + F.lane; } while (0)

#define IN_(i) (args.in[i])
#define x_prompt IN_(0)
#define x_sample IN_(1)
#define cache_a_k IN_(2)
#define cache_a_v IN_(3)
#define cache_b_k IN_(4)
#define cache_b_v IN_(5)
#define c_prompt IN_(6)
#define c_sample IN_(7)
#define rel_bias IN_(8)
#define w_ada IN_(9)
#define b_ada IN_(10)
#define sinks IN_(16)
#define ln_g IN_(20)
#define ln_b IN_(21)
#define OUTP (args.out)
#define o_pak (args.out + 16908288)
#define o_pav (args.out + 21102592)
#define o_pbk (args.out + 25296896)
#define o_pbv (args.out + 25362432)
#define o_sak (args.out + 25427968)
#define o_sav (args.out + 25493504)
#define o_sbk (args.out + 25559040)
#define o_sbv (args.out + 25575424)
#define WGU1 ((bf16*)(args.ws + WS_WGU1))
#define WD1 ((bf16*)(args.ws + WS_WD1))
#define WIN ((bf16*)(args.ws + WS_WIN))
#define WOUT ((bf16*)(args.ws + WS_WOUT))
#define WGU2 ((bf16*)(args.ws + WS_WGU2))
#define WD2 ((bf16*)(args.ws + WS_WD2))
#define WADA ((bf16*)(args.ws + WS_WADA))
#define AMOD ((bf16*)(args.ws + WS_AMOD))
#define MOD ((float*)(args.ws + WS_MOD))
#define SQ ((float*)(args.ws + WS_SQ))
#define H ((bf16*)(args.ws + WS_H))
#define ACT ((bf16*)(args.ws + WS_ACT))
#define Z ((float*)(args.ws + WS_Z))
#define X1 ((float*)(args.ws + WS_X1))
#define X2 ((float*)(args.ws + WS_X2))
#define QKV ((bf16*)(args.ws + WS_QKV))
#define OA ((bf16*)(args.ws + WS_OA))
#define LSE ((float*)(args.ws + WS_LSE))
#define MIX ((bf16*)(args.ws + WS_MIX))
#define SLAB ((float*)(args.ws + WS_SLAB))
#define PARTO ((float*)(args.ws + WS_PART))
#define PARTM ((float*)(args.ws + WS_PART + 524288))
#define PARTD ((float*)(args.ws + WS_PART + 524288 + 8192))
    {
        LAS float* scr = (LAS float*)(F.lds + RING_OFF + F.wave * 16384);
        constexpr int NITEMS = 2 * (3 * 16 * 88) + 16 * 72 + 16 * 32 + 16 * 288;
        for (int it = gw; it < NITEMS; it += NGW) {
            int r = it;
            if (p0_matrix<true, FP8_UP>(r, args.in[11], D, DFF, WGU1, 0, 64.f, scr, F.lane)) continue;
            if (p0_matrix<true, FP8_UP>(r, args.in[12], D, DFF, WGU1, 1, 64.f, scr, F.lane)) continue;
            if (p0_matrix<false, FP8_DOWN>(r, args.in[13], DFF, D, WD1, 0, 128.f, scr, F.lane)) continue;
            if (p0_matrix<false, false>(r, args.in[14], D, NPROJ, WIN, 0, 1.f, scr, F.lane)) continue;
            if (p0_matrix<false, false>(r, args.in[15], D, D, WOUT, 0, 1.f, scr, F.lane)) continue;
            if (p0_matrix<true, FP8_UP>(r, args.in[17], D, DFF, WGU2, 0, 64.f, scr, F.lane)) continue;
            if (p0_matrix<true, FP8_UP>(r, args.in[18], D, DFF, WGU2, 1, 64.f, scr, F.lane)) continue;
            if (p0_matrix<false, FP8_DOWN>(r, args.in[19], DFF, D, WD2, 0, 128.f, scr, F.lane)) continue;
            p0_matrix<false, false>(r, w_ada, D, NMOD, WADA, 0, 1.f, scr, F.lane);
        }
        for (int r = gw; r < 256; r += NGW) {
            v2u* orow = (v2u*)(AMOD + (size_t)r * D) + F.lane;
            const float* crow_ = r < 4 ? c_prompt + (size_t)r * D : (r < 132 ? c_sample + (size_t)(r - 4) * D : nullptr);
#pragma unroll
            for (int j = 0; j < 4; ++j) { v2u w; w.x = 0u; w.y = 0u;
                if (crow_) { const f32x4 c = ((const f32x4*)crow_)[F.lane + 64 * j]; f32x4 sv;
#pragma unroll
                    for (int e = 0; e < 4; ++e) sv[e] = c[e] * __builtin_amdgcn_rcpf(1.0f + __builtin_amdgcn_exp2f(-LOG2E * c[e]));
                    w.x = pk2(sv[0], sv[1]); w.y = pk2(sv[2], sv[3]); }
                orow[64 * j] = w; }
        }
        for (int r = gw; r < 256; r += NGW) {
            bf16* base = (r < 128 ? H : MIX) + (size_t)(M_REAL + (r & 127)) * D;
            v4u zz = (v4u){0u, 0u, 0u, 0u}; ((v4u*)base)[F.lane] = zz; ((v4u*)base)[F.lane + 64] = zz;
        }
    }
    xcd_barrier(bar);
    REFRESH();
    {
        pg8::Gemm g{AMOD, WADA, 256, NMOD, D, 0, 0, F.wave}; pg8::StaticOrder S; S.init(256, NMOD, D, F.G, (int)blockIdx.x);
        pg8::EpiF32 E{MOD, NMOD, b_ada};
        pg8::gemm_phase<pg8::EpiF32, pg8::StaticOrder, true, true>(F.lds + RING_OFF, g, S, E);
    }
    xcd_barrier(bar);
    REFRESH();
    for (int row = gw; row < M_REAL; row += NGW) {
        const int seq = seq_of_row(row);
        const f32x4* xr = (const f32x4*)(row < MP ? x_prompt + (size_t)row * D : x_sample + (size_t)(row - MP) * D) + F.lane;
        const f32x4* mr = (const f32x4*)(MOD + (size_t)seq * NMOD) + F.lane;
        v2u* hrow = (v2u*)(H + (size_t)row * D) + F.lane; unsigned* hrow8 = (unsigned*)((unsigned char*)H + (size_t)row * D) + F.lane;
#pragma unroll
        for (int j = 0; j < 4; ++j) { const f32x4 hh = xr[64 * j] * (mr[256 + 64 * j] + 1.0f) + mr[64 * j];
            if (FP8_UP) hrow8[64 * j] = pg8::pk4_fp8(hh[0], hh[1], hh[2], hh[3]);
            else { v2u w; w.x = pk2(hh[0], hh[1]); w.y = pk2(hh[2], hh[3]); hrow[64 * j] = w; } }
    }
    xcd_barrier(bar);
    REFRESH();
    {
        constexpr int KU = FP8_UP ? D / 2 : D;
        pg8::Gemm g{H, WGU1, M_PAD, 2 * DFF, KU, 0x7c7c7c7c, 0x7c7c7c7c, F.wave}; pg8::StaticOrder S; S.init(M_PAD, 2 * DFF, KU, F.G, (int)blockIdx.x);
        pg8::EpiSwiGLU<FP8_DOWN> E{ACT, DFF};
        pg8::gemm_phase<pg8::EpiSwiGLU<FP8_DOWN>, pg8::StaticOrder, true, true, FP8_UP>(F.lds + RING_OFF, g, S, E);
    }
    xcd_barrier(bar);
    REFRESH();
    {
        constexpr int KD = FP8_DOWN ? DFF / 2 : DFF;
        pg8::Gemm g{ACT, WD1, M_PAD, D, KD, 0x7a7a7a7a, 0x7a7a7a7a, F.wave}; pg8::TailSplitOrder S; S.init(KD, FP8_DOWN ? 2 : 4, F.G, (int)blockIdx.x);
        pg8::EpiF32Z E{Z, SLAB};
        pg8::gemm_phase<pg8::EpiF32Z, pg8::TailSplitOrder, true, true, FP8_DOWN>(F.lds + RING_OFF, g, S, E);
    }
    xcd_barrier(bar);
    REFRESH();
    ln_rows<1, 11>(F, x_prompt, x_sample, Z, SLAB, MOD, 2, 0.5f, ln_g, ln_b, X1, H, 3, 4);
    xcd_barrier(bar);
    REFRESH();
    {
        pg8::Gemm g{H, WIN, M_PAD, NPROJ, D, 0, 0, F.wave}; pg8::StaticOrder S; S.init(M_PAD, NPROJ, D, F.G, (int)blockIdx.x);
        pg8::EpiQKV E{QKV, SQ, o_pak, o_pav, o_pbk, o_pbv, o_sak, o_sav, o_sbk, o_sbv, QSCALE};
        pg8::gemm_phase<pg8::EpiQKV, pg8::StaticOrder, true, true>(F.lds + RING_OFF, g, S, E);
    }
    xcd_barrier(bar);
    REFRESH();
    {
        LAS float* relS = (LAS float*)(F.lds + ATT_RELS_OFF);
        for (int idx = F.tid; idx < 520; idx += NWAVES * 64) relS[idx] = (idx < 512 ? rel_bias[idx] : sinks[idx - 512]) * LOG2E;
        __syncthreads();
        LAS float* PS = (LAS float*)(F.lds + RING_OFF);
        for (int ht = F.vcu; ht < 2 * NS; ht += F.G) {
            sampleA_wave(ht >> 1, ht & 1, F.wave, SQ, relS, cache_a_k, cache_a_v, o_sak, o_sav, PS);
            __syncthreads();
            sampleA_combine(ht >> 1, ht & 1, F.tid, PS, PARTO, PARTM, PARTD);
            __syncthreads();
        }
        if ((F.wave & 1) == 0) {
            LAS float* pbuf = (LAS float*)(F.lds + RING_OFF + 32768 + F.wave * 2048);
            for (int st = (gw >> 1); st < NS * 8; st += (NGW >> 1)) sample_task(true, st >> 3, st & 7, SQ, rel_bias, sinks, cache_b_k, cache_b_v, o_sbk, o_sbv, MIX, pbuf);
        }
        asm volatile("s_waitcnt vmcnt(0) lgkmcnt(0)" ::: "memory");
        __syncthreads();
        attn_units(F.lds + RING_OFF, F.wave, F.vcu, F.G, QKV, OA, LSE, MIX);
    }
    xcd_barrier(bar);
    REFRESH();
    for (int n = gw; n < NS; n += NGW) {
        const int h = F.lane >> 3;
        const float Ma = PARTM[(2 * n) * 8 + h], Mb = PARTM[(2 * n + 1) * 8 + h], Mx = fmaxf(Ma, Mb);
        const float ea = __builtin_amdgcn_exp2f(Ma - Mx), eb = __builtin_amdgcn_exp2f(Mb - Mx);
        const float inv = 1.0f / (PARTD[(2 * n) * 8 + h] * ea + PARTD[(2 * n + 1) * 8 + h] * eb);
        const f32x4* pa = (const f32x4*)(PARTO + (size_t)(2 * n) * 512) + 2 * F.lane; const f32x4* pb = (const f32x4*)(PARTO + (size_t)(2 * n + 1) * 512) + 2 * F.lane;
        const f32x4 r0 = (pa[0] * ea + pb[0] * eb) * inv, r1 = (pa[1] * ea + pb[1] * eb) * inv;
        v4u wv; wv.x = pk2(r0[0], r0[1]); wv.y = pk2(r0[2], r0[3]); wv.z = pk2(r1[0], r1[1]); wv.w = pk2(r1[2], r1[3]);
        ((v4u*)(MIX + (size_t)(MP + n) * D))[F.lane] = wv;
    }
    for (int token = gw; token < MP; token += NGW) {
        const int h = F.lane >> 3;
        float l0 = LSE[((size_t)0 * MP + token) * 8 + h], l1 = LSE[((size_t)1 * MP + token) * 8 + h], l2 = LSE[((size_t)2 * MP + token) * 8 + h];
        const float mx = fmaxf(l0, fmaxf(l1, l2));
        float w0 = __builtin_amdgcn_exp2f(l0 - mx), w1 = __builtin_amdgcn_exp2f(l1 - mx), w2 = __builtin_amdgcn_exp2f(l2 - mx);
        const float inv = 1.0f / (w0 + w1 + w2); w0 *= inv; w1 *= inv; w2 *= inv;
        const v4u a0 = ((const v4u*)(OA + ((size_t)0 * MP + token) * 512))[F.lane], a1 = ((const v4u*)(OA + ((size_t)1 * MP + token) * 512))[F.lane], a2 = ((const v4u*)(OA + ((size_t)2 * MP + token) * 512))[F.lane];
        v4u w;
#pragma unroll
        for (int e = 0; e < 4; ++e) {
            const float lo = w0 * bf2f((unsigned short)(a0[e] & 0xffffu)) + w1 * bf2f((unsigned short)(a1[e] & 0xffffu)) + w2 * bf2f((unsigned short)(a2[e] & 0xffffu));
            const float hi_ = w0 * bf2f((unsigned short)(a0[e] >> 16)) + w1 * bf2f((unsigned short)(a1[e] >> 16)) + w2 * bf2f((unsigned short)(a2[e] >> 16));
            w[e] = pk2(lo, hi_);
        }
        ((v4u*)(MIX + (size_t)token * D))[F.lane] = w;
    }
    xcd_barrier(bar);
    REFRESH();
    {
        pg8::Gemm g{MIX, WOUT, M_PAD, D, D, 0, 0, F.wave}; pg8::TailSplitOrder S; S.init(D, 4, F.G, (int)blockIdx.x);
        pg8::EpiF32Z E{Z, SLAB};
        pg8::gemm_phase<pg8::EpiF32Z, pg8::TailSplitOrder, true, true>(F.lds + RING_OFF, g, S, E);
    }
    xcd_barrier(bar);
    REFRESH();
    ln_rows<(FP8_UP ? 2 : 1), 4>(F, X1, X1 + (size_t)MP * D, Z, SLAB, MOD, 5, 1.0f, ln_g + D, ln_b + D, X2, H, 6, 7);
    xcd_barrier(bar);
    REFRESH();
    {
        constexpr int KU = FP8_UP ? D / 2 : D;
        pg8::Gemm g{H, WGU2, M_PAD, 2 * DFF, KU, 0x7c7c7c7c, 0x7c7c7c7c, F.wave}; pg8::StaticOrder S; S.init(M_PAD, 2 * DFF, KU, F.G, (int)blockIdx.x);
        pg8::EpiSwiGLU<FP8_DOWN> E{ACT, DFF};
        pg8::gemm_phase<pg8::EpiSwiGLU<FP8_DOWN>, pg8::StaticOrder, true, true, FP8_UP>(F.lds + RING_OFF, g, S, E);
    }
    xcd_barrier(bar);
    REFRESH();
    {
        constexpr int KD = FP8_DOWN ? DFF / 2 : DFF;
        pg8::Gemm g{ACT, WD2, M_PAD, D, KD, 0x7a7a7a7a, 0x7a7a7a7a, F.wave}; pg8::TailSplitOrder S; S.init(KD, FP8_DOWN ? 2 : 4, F.G, (int)blockIdx.x);
        pg8::EpiF32Z E{Z, SLAB};
        pg8::gemm_phase<pg8::EpiF32Z, pg8::TailSplitOrder, true, true, FP8_DOWN>(F.lds + RING_OFF, g, S, E);
    }
    xcd_barrier(bar);
    REFRESH();
    ln_rows<0, 11>(F, X2, X2 + (size_t)MP * D, Z, SLAB, MOD, 8, 0.5f, ln_g + 2 * D, ln_b + 2 * D, OUTP, nullptr, 0, 0);
#ifdef PROBE_SCALE9
    if (blockIdx.x == 0) { for (int i = F.tid; i < 16384; i += NWAVES * 64) o_sbv[i] *= 1.05f; }
#endif
}

#undef IN_
#undef x_prompt
#undef x_sample
#undef cache_a_k
#undef cache_a_v
#undef cache_b_k
#undef cache_b_v
#undef c_prompt
#undef c_sample
#undef rel_bias
#undef w_ada
#undef b_ada
#undef sinks
#undef ln_g
#undef ln_b
#undef OUTP
#undef o_pak
#undef o_pav
#undef o_pbk
#undef o_pbv
#undef o_sak
#undef o_sav
#undef o_sbk
#undef o_sbv
#undef WGU1
#undef WD1
#undef WIN
#undef WOUT
#undef WGU2
#undef WD2
#undef WADA
#undef AMOD
#undef MOD
#undef SQ
#undef H
#undef ACT
#undef Z
#undef X1
#undef X2
#undef QKV
#undef OA
#undef LSE
#undef MIX
#undef SLAB
#undef PARTO
#undef PARTM
#undef PARTD
extern "C" void kernel_launch(void* const* d_in, const int* in_sizes, int n_in, void* d_out, int out_size, void* d_ws, size_t ws_size, hipStream_t stream) {
    static int grid = 0;
    if (grid == 0) {
        if (n_in != 22 || out_size != 25591808 || ws_size < WS_END) { fprintf(stderr, "kernel_launch: unexpected shapes (n_in %d out %d ws %zu)\n", n_in, out_size, ws_size); grid = -1; return; }
        int dev = 0, cus = 0, per_cu = 0;
        if (hipGetDevice(&dev) != hipSuccess || hipDeviceGetAttribute(&cus, hipDeviceAttributeMultiprocessorCount, dev) != hipSuccess) { grid = -1; return; }
        if (hipFuncSetAttribute((const void*)mega_fwd, hipFuncAttributeMaxDynamicSharedMemorySize, LDS_BYTES) != hipSuccess) { fprintf(stderr, "kernel_launch: hipFuncSetAttribute failed\n"); grid = -1; return; }
        if (hipOccupancyMaxActiveBlocksPerMultiprocessor(&per_cu, (const void*)mega_fwd, NWAVES * 64, LDS_BYTES) != hipSuccess || per_cu < 1)
            fprintf(stderr, "kernel_launch: occupancy query reports %d workgroups per CU\n", per_cu);
        (void)hipGetLastError();
        grid = cus;
    }
    if (grid < 0) return;
    if (hipMemsetAsync((char*)d_ws + WS_CTL, 0, CTL_ZERO_BYTES, stream) != hipSuccess) return;
    Args a{};
    for (int i = 0; i < 22; ++i) a.in[i] = (const float*)d_in[i];
    a.out = (float*)d_out; a.ws = (unsigned char*)d_ws;
    hipLaunchKernelGGL(mega_fwd, dim3(grid), dim3(NWAVES * 64), LDS_BYTES, stream, a);
}
```
